# Optimizing an MI355X kernel written in HIP

```python
import jax, jax.numpy as jnp
from jax import lax
import numpy as np

D_MODEL = 1024
BATCH = 8
SEQ = 2048
DEPTH = 2
DEC_BATCH = 128
DEC_SEQ = 4
PAST_LEN = 16384
PAGE_SIZE = 128

EXPAND = 2
MIX_WIDTH = EXPAND * D_MODEL
RW_HEAD = 64
RW_HEADS = MIX_WIDTH // RW_HEAD
LORA_W = 64
LORA_A = 64
SHIFT_COLS = 3 * MIX_WIDTH + LORA_W + LORA_A
RW_IN_COLS = SHIFT_COLS + MIX_WIDTH
GN_EPS = 64e-5
CHUNK = 128
GM_GROUPS = 8
GM_GROUP_DIM = MIX_WIDTH // GM_GROUPS
GM_IN_COLS = 3 * MIX_WIDTH
N_RWKV = (DEPTH + 1) // 2
N_GMLP = DEPTH // 2
NORM_EPS = 1e-6
LN_EPS = 1e-5

kernel_name = "hybrid_rwkv7_gmlp_decode_step"


def _rmsnorm(x, g):
    xf = x.astype(jnp.float32)
    y = xf * lax.rsqrt(jnp.mean(xf * xf, axis=-1, keepdims=True) + NORM_EPS)
    return y.astype(x.dtype) * g


def _wkv7_scan(r, decay, k, v, kk, a, s0):
    xs = tuple(jnp.swapaxes(arr, 0, 1) for arr in (r, decay, k, v, kk, a))

    def step(S, inp):
        r_t, w_t, k_t, v_t, kk_t, a_t = inp
        sa = jnp.einsum('bhvk,bhk->bhv', S, -kk_t)
        S = (S * w_t[:, :, None, :]
             + sa[..., None] * (kk_t * a_t)[:, :, None, :]
             + v_t[..., None] * k_t[:, :, None, :])
        return S, jnp.einsum('bhvk,bhk->bhv', S, r_t)

    S, ys = lax.scan(step, s0, xs)
    return jnp.swapaxes(ys, 0, 1), S


def _rwkv7_mixer(h, shift_prev, wkv0, w_in, mu, w0, w2, a0, a2, k_k, k_a, r_k, lnx_g, lnx_b, w_out):
    bt, t, _ = h.shape
    proj = h @ w_in
    sh, z = proj[..., :SHIFT_COLS], proj[..., SHIFT_COLS:]
    prev = jnp.concatenate([shift_prev[:, None, :].astype(sh.dtype), sh[:, :-1]], axis=1)
    xm = sh + (prev - sh) * mu
    e = MIX_WIDTH
    r, k, v = xm[..., :e], xm[..., e:2 * e], xm[..., 2 * e:3 * e]
    wd = xm[..., 3 * e:3 * e + LORA_W]
    ad = xm[..., 3 * e + LORA_W:]
    wf = (w0 + jnp.tanh(wd) @ w2).astype(jnp.float32)
    w_log = -jax.nn.softplus(-wf) - 0.5
    decay = jnp.exp(-jnp.exp(w_log))
    a = jax.nn.sigmoid((a0 + ad @ a2).astype(jnp.float32))

    hs = lambda u: u.astype(jnp.float32).reshape(bt, t, RW_HEADS, RW_HEAD)
    hp = lambda p: p.astype(jnp.float32).reshape(RW_HEADS, RW_HEAD)
    r, k, v, a, decay = hs(r), hs(k), hs(v), hs(a), hs(decay)
    kk = k * hp(k_k)
    kk = kk / jnp.maximum(jnp.sqrt(jnp.sum(kk * kk, axis=-1, keepdims=True)), 1e-12)
    k = k * (1.0 + (a - 1.0) * hp(k_a))

    y, s_fin = _wkv7_scan(r, decay, k, v, kk, a, wkv0.astype(jnp.float32))
    mean = jnp.mean(y, axis=-1, keepdims=True)
    var = jnp.mean(jnp.square(y - mean), axis=-1, keepdims=True)
    yn = ((y - mean) * lax.rsqrt(var + GN_EPS)).reshape(bt, t, e)
    yn = yn * lnx_g.astype(jnp.float32) + lnx_b.astype(jnp.float32)
    bonus = jnp.sum(r * k * r_k.astype(jnp.float32), axis=-1, keepdims=True) * v
    o = (yn + bonus.reshape(bt, t, e)).astype(h.dtype) * jax.nn.silu(z)
    return o @ w_out, sh[:, -1], s_fin.astype(wkv0.dtype)


def _gmlp_mixer(h, w_in, v_g, v_b, ws, bs, w_out):
    bt, t, _ = h.shape
    e = MIX_WIDTH
    proj = h @ w_in
    u = jax.nn.gelu(proj[..., :e])
    v = jax.nn.gelu(proj[..., e:2 * e])
    z = proj[..., 2 * e:]
    vf = v.astype(jnp.float32)
    vm_ = jnp.mean(vf, axis=-1, keepdims=True)
    vv = jnp.mean(jnp.square(vf - vm_), axis=-1, keepdims=True)
    v = ((vf - vm_) * lax.rsqrt(vv + LN_EPS)).astype(h.dtype) * v_g + v_b
    n_chunks = -(-t // CHUNK)
    pad = n_chunks * CHUNK - t
    vp = jnp.pad(v, ((0, 0), (0, pad), (0, 0))).reshape(bt, n_chunks, CHUNK, GM_GROUPS, GM_GROUP_DIM)
    mask = jnp.tril(jnp.ones((CHUNK, CHUNK), dtype=bool))
    wm = jnp.where(mask[None], ws, jnp.zeros_like(ws))
    mixed = jnp.einsum('gts,bcsgd->bctgd', wm, vp) + bs.T[None, None, :, :, None]
    mixed = mixed.reshape(bt, n_chunks * CHUNK, e)[:, :t]
    o = u * mixed * jax.nn.silu(z)
    return o @ w_out, v


def setup_inputs(seed: int = 0) -> dict:
    key = jax.random.key(seed)
    ks = jax.random.split(key, 26)
    f32 = jnp.float32
    nrm = lambda k, shape, s: jax.random.normal(k, shape, f32) * s
    e = MIX_WIDTH
    return {
        "x_prompt": nrm(ks[0], (BATCH, SEQ, D_MODEL), 1.0),
        "x_sample": nrm(ks[1], (DEC_BATCH, DEC_SEQ, D_MODEL), 1.0),
        "state_shift": nrm(ks[2], (N_RWKV, DEC_BATCH, SHIFT_COLS), 1.0),
        "state_wkv": nrm(ks[3], (N_RWKV, DEC_BATCH, RW_HEADS, RW_HEAD, RW_HEAD), 0.3),
        "norm_g": 1.0 + nrm(ks[4], (DEPTH, D_MODEL), 0.05),
        "norm_f": 1.0 + nrm(ks[5], (D_MODEL,), 0.05),
        "rw_in": nrm(ks[6], (N_RWKV, D_MODEL, RW_IN_COLS), D_MODEL ** -0.5),
        "rw_mu": jax.random.uniform(ks[7], (N_RWKV, SHIFT_COLS), f32),
        "rw_w0": jax.random.uniform(ks[8], (N_RWKV, e), f32, -6.0, 1.0),
        "rw_w2": nrm(ks[9], (N_RWKV, LORA_W, e), 0.1),
        "rw_a0": nrm(ks[10], (N_RWKV, e), 0.5),
        "rw_a2": nrm(ks[11], (N_RWKV, LORA_A, e), 0.1),
        "rw_kk": 0.85 + nrm(ks[12], (N_RWKV, e), 0.05),
        "rw_ka": 1.0 + nrm(ks[13], (N_RWKV, e), 0.05),
        "rw_rk": nrm(ks[14], (N_RWKV, RW_HEADS, RW_HEAD), 0.1),
        "rw_lnx_g": 1.0 + nrm(ks[15], (N_RWKV, e), 0.05),
        "rw_lnx_b": nrm(ks[16], (N_RWKV, e), 0.05),
        "rw_out": nrm(ks[17], (N_RWKV, e, D_MODEL), e ** -0.5),
        "gm_in": nrm(ks[18], (N_GMLP, D_MODEL, GM_IN_COLS), D_MODEL ** -0.5),
        "gm_vg": 1.0 + nrm(ks[19], (N_GMLP, e), 0.05),
        "gm_vb": nrm(ks[20], (N_GMLP, e), 0.05),
        "gm_ws": nrm(ks[21], (N_GMLP, GM_GROUPS, CHUNK, CHUNK), CHUNK ** -0.5),
        "gm_bs": 1.0 + nrm(ks[22], (N_GMLP, GM_GROUPS, CHUNK), 0.1),
        "gm_out": nrm(ks[23], (N_GMLP, e, D_MODEL), e ** -0.5),
    }


def reference(x_prompt, x_sample, state_shift, state_wkv, norm_g, norm_f,
              rw_in, rw_mu, rw_w0, rw_w2, rw_a0, rw_a2, rw_kk, rw_ka, rw_rk, rw_lnx_g, rw_lnx_b, rw_out,
              gm_in, gm_vg, gm_vb, gm_ws, gm_bs, gm_out):
    xp, xs = x_prompt, x_sample
    p_shift, p_wkv, s_shift, s_wkv, s_v = [], [], [], [], []
    for i in range(DEPTH):
        j = i // 2
        hp = _rmsnorm(xp, norm_g[i])
        hs = _rmsnorm(xs, norm_g[i])
        if i % 2 == 0:
            prm = (rw_in[j], rw_mu[j], rw_w0[j], rw_w2[j], rw_a0[j], rw_a2[j], rw_kk[j], rw_ka[j],
                   rw_rk[j], rw_lnx_g[j], rw_lnx_b[j], rw_out[j])
            sh0 = jnp.zeros((xp.shape[0], SHIFT_COLS), xp.dtype)
            wkv0 = jnp.zeros((xp.shape[0], RW_HEADS, RW_HEAD, RW_HEAD), state_wkv.dtype)
            op, shp, wkp = _rwkv7_mixer(hp, sh0, wkv0, *prm)
            os_, shs, wks = _rwkv7_mixer(hs, state_shift[j], state_wkv[j], *prm)
            p_shift.append(shp); p_wkv.append(wkp); s_shift.append(shs); s_wkv.append(wks)
        else:
            prm = (gm_in[j], gm_vg[j], gm_vb[j], gm_ws[j], gm_bs[j], gm_out[j])
            op, _ = _gmlp_mixer(hp, *prm)
            os_, vs = _gmlp_mixer(hs, *prm)
            s_v.append(vs)
        xp = xp + op
        xs = xs + os_
    y_prompt = _rmsnorm(xp, norm_f)
    y_sample = _rmsnorm(xs, norm_f)
    prompt_shift = jnp.stack(p_shift)
    prompt_wkv = jnp.stack(p_wkv)
    sample_shift = jnp.stack(s_shift)
    sample_wkv = jnp.stack(s_wkv)
    sample_v = jnp.stack(s_v)
    return (y_prompt, y_sample, prompt_shift, prompt_wkv, sample_shift, sample_wkv, sample_v)
```

```cpp
#include <hip/hip_runtime.h>
#include <hip/hip_cooperative_groups.h>
#include <cstdio>
namespace cg = cooperative_groups;

#ifndef MK_ONE_LAUNCH
#define MK_ONE_LAUNCH 1
#endif

#define LAS __attribute__((address_space(3)))
typedef unsigned short bf16_t;
typedef short bf16x8 __attribute__((ext_vector_type(8)));
typedef float f32x4 __attribute__((ext_vector_type(4)));
typedef unsigned u32x2 __attribute__((ext_vector_type(2)));
typedef unsigned u32x4 __attribute__((ext_vector_type(4)));

constexpr int D = 1024, E = 2048, NH = 32, SHIFTC = 6272, RWIN = 8320, RWIN_PAD = 8448, GMIN = 6144;
constexpr int MP = 16384, MS = 512, MTOT = 16896;
constexpr int PA_ROWS = 8192, PB_ROWS = 8704;
constexpr int NTHREADS = 512, NWAVES = 8;
constexpr int LDS_BYTES = 132096;
constexpr size_t OFF_Y = 0, OFF_PSHIFT = 17301504, OFF_PWKV = 17351680, OFF_SSHIFT = 18400256, OFF_SWKV = 19203072, OFF_SV = 35980288;
constexpr size_t MiB = 1u << 20;
constexpr size_t WS_O = 0, WS_PROJH = 66 * MiB, WS_W1T = 204 * MiB + 512 * 1024, WS_X1B = 198 * MiB, WS_PROJ2 = 0;
constexpr size_t WS_W3T = 231 * MiB, WS_W4T = 243 * MiB, WS_W2T = 247 * MiB, WS_MISC = 251 * MiB;
constexpr int MI_RS0 = 0, MI_SS1 = 16896, MI_VSUM = 2 * 16896, MI_VSQ = 3 * 16896, MI_SS2 = 4 * 16896, MI_CARRY = 5 * 16896;

struct Params { const float* in[24]; float* out; unsigned char* ws; int ph_lo, ph_hi; };

__device__ __forceinline__ unsigned pk2(float lo, float hi) { unsigned r; asm("v_cvt_pk_bf16_f32 %0, %1, %2" : "=v"(r) : "v"(lo), "v"(hi)); return r; }
__device__ __forceinline__ float bf2f(bf16_t b) { return __uint_as_float(((unsigned)b) << 16); }
__device__ __forceinline__ float bflo(unsigned u) { return __uint_as_float(u << 16); }
__device__ __forceinline__ float bfhi(unsigned u) { return __uint_as_float(u & 0xffff0000u); }
__device__ __forceinline__ float wave_sum(float v) {
#pragma unroll
    for (int o = 1; o < 64; o <<= 1) v += __shfl_xor(v, o);
    return v;
}
__device__ __forceinline__ float sigmoidf_(float x) { return 1.f / (1.f + __expf(-x)); }
__device__ __forceinline__ float gelu_tanh(float x) { const float u = 1.5957691216057308f * (x + 0.044715f * x * x * x); return x / (1.f + __expf(-u)); }
#define LDS_WAIT() asm volatile("s_waitcnt lgkmcnt(0)" ::: "memory")

namespace pg8 {
constexpr int BM = 256, BK = 64, HALF = 128, HTB = HALF * BK * 2, STAGE_BYTES = 8 * HTB, NXCD = 8, WGM = 8;
__host__ __device__ __forceinline__ int lds_byte(int r, int c) { const int st = (r >> 4) * 2 + (c >> 5), rr = r & 15, cc = c & 31, ob = rr * 64 + cc * 2; return st * 1024 + (ob ^ (((ob >> 9) & 1) << 5)); }
__host__ __device__ __forceinline__ void stage_rc(int b, int& R, int& C) { const int st = b / 1024, sb = b % 1024, swz = sb ^ (((sb >> 9) & 1) << 5); R = (st >> 1) * 16 + swz / 64; C = (st & 1) * 32 + (swz % 64) / 2; }
struct Unit { int pm, pn; };
struct Gemm { const bf16_t* A; const bf16_t* Bt; int M, N, K, lda; };
struct StaticOrder {
    int nM, nN, nwg, G, c;
    __device__ void init(int M, int N, int G_, int c_) { nM = M / BM; nN = N / BM; nwg = nM * nN; G = G_; c = c_; }
    __device__ bool next(int i, Unit& u) const {
        const long L = (long)i * G + c; if (L >= nwg) return false;
        int wgid = (int)L; { const int q = nwg / NXCD, r = nwg % NXCD, xcd = wgid % NXCD, off = wgid / NXCD; wgid = (xcd < r ? xcd * (q + 1) : r * (q + 1) + (xcd - r) * q) + off; }
        const int nig = WGM * nN, gid = wgid / nig, fm = gid * WGM, gsz = (nM - fm) < WGM ? (nM - fm) : WGM;
        u.pm = fm + ((wgid % nig) % gsz); u.pn = (wgid % nig) / gsz; return true;
    }
};
template <class Epi>
__device__ __forceinline__ void gemm_phase(LAS unsigned char* lds, const Gemm g, const StaticOrder& S, const Epi& E) {
    const int tid = threadIdx.x, wid = __builtin_amdgcn_readfirstlane(tid >> 6), lane = tid & 63, wr = wid >> 2, wc = wid & 3, fr = lane & 15, fq = lane >> 4;
    const int K = g.K, nt = K / BK, lda = g.lda;
    unsigned voffA[2], voffB[2];
#pragma unroll
    for (int i = 0; i < 2; ++i) { int R, C; stage_rc(tid * 16 + i * 8192, R, C); voffA[i] = (unsigned)(R * lda + C) * 2u; voffB[i] = (unsigned)(R * K + C) * 2u; }
    const size_t kstep = (size_t)(BK * 2);
    const size_t hstepA = (size_t)HALF * lda * 2, hstepB = (size_t)HALF * K * 2;
    const size_t tstepA = 2 * hstepA, tstepB = 2 * hstepB;
    const unsigned ldsw = (unsigned)wid * 1024u;
    const int aoff = lds_byte(wr * 64 + fr, fq * 8), boff = lds_byte(wc * 32 + fr, fq * 8);
#define PG8_SA(b, h) (((b) * 2 + (h)) * HTB)
#define PG8_SB(b, h) ((4 + (b) * 2 + (h)) * HTB)
#define PG8_STAGE(bufoff, gbase, voff) do { _Pragma("unroll") for (int _i = 0; _i < 2; ++_i) \
        __builtin_amdgcn_global_load_lds((const unsigned*)((const char*)(gbase) + (voff)[_i]), (LAS unsigned*)(lds + (bufoff) + ldsw + _i * 8192), 16, 0, 0); } while (0)
#define PG8_LDA(dst, b, h) do { _Pragma("unroll") for (int m = 0; m < 4; ++m) _Pragma("unroll") for (int k = 0; k < 2; ++k) dst[m][k] = *(const LAS bf16x8*)(lds + PG8_SA(b, h) + aoff + m * 2048 + k * 1024); } while (0)
#define PG8_LDB(dst, b, h) do { _Pragma("unroll") for (int n = 0; n < 2; ++n) _Pragma("unroll") for (int k = 0; k < 2; ++k) dst[n][k] = *(const LAS bf16x8*)(lds + PG8_SB(b, h) + boff + n * 2048 + k * 1024); } while (0)
#define PG8_MMA(ai, bj, At, Bt) do { __builtin_amdgcn_s_setprio(1); _Pragma("unroll") for (int m = 0; m < 4; ++m) _Pragma("unroll") for (int n = 0; n < 2; ++n) _Pragma("unroll") for (int k = 0; k < 2; ++k) \
        acc[ai][bj][m][n] = __builtin_amdgcn_mfma_f32_16x16x32_bf16(Bt[n][k], At[m][k], acc[ai][bj][m][n], 0, 0, 0); __builtin_amdgcn_s_setprio(0); } while (0)
#define PG8_WAIT_V(n) asm volatile("s_waitcnt vmcnt(" #n ")" ::: "memory")
#define PG8_WAIT_L(n) asm volatile("s_waitcnt lgkmcnt(" #n ")" ::: "memory")
#define PG8_BAR __builtin_amdgcn_s_barrier()
#define PG8_SCHED __builtin_amdgcn_sched_barrier(0)
    Unit cur, nxt; int ui = 0;
    if (!S.next(0, cur)) return;
    f32x4 acc[2][2][4][2];
#pragma unroll
    for (int a = 0; a < 2; ++a)
#pragma unroll
        for (int b = 0; b < 2; ++b)
#pragma unroll
            for (int m = 0; m < 4; ++m)
#pragma unroll
                for (int n = 0; n < 2; ++n) acc[a][b][m][n] = (f32x4){0.f, 0.f, 0.f, 0.f};
    bf16x8 At[4][2], B0[2][2], B1[2][2];
    const char* cA = (const char*)g.A + (size_t)cur.pm * tstepA; const char* cB = (const char*)g.Bt + (size_t)cur.pn * tstepB;
    PG8_STAGE(PG8_SB(0, 0), cB, voffB); PG8_STAGE(PG8_SA(0, 0), cA, voffA); PG8_STAGE(PG8_SB(0, 1), cB + hstepB, voffB); PG8_STAGE(PG8_SA(0, 1), cA + hstepA, voffA);
    if (wr == 1) PG8_BAR;
    PG8_WAIT_V(4); PG8_BAR;
    PG8_STAGE(PG8_SB(1, 0), cB + kstep, voffB); PG8_STAGE(PG8_SA(1, 0), cA + kstep, voffA); PG8_STAGE(PG8_SB(1, 1), cB + hstepB + kstep, voffB);
    PG8_WAIT_V(6); PG8_BAR;
    for (;;) {
        const bool has_next = S.next(ui + 1, nxt);
        const char* nA = has_next ? (const char*)g.A + (size_t)nxt.pm * tstepA : cA; const char* nB = has_next ? (const char*)g.Bt + (size_t)nxt.pn * tstepB : cB;
        for (int t = 0; t < nt; t += 2) {
            const bool last = (t == nt - 2);
            const char* a1 = cA + (size_t)(t + 1) * kstep;
            const char* a2 = last ? nA : cA + (size_t)(t + 2) * kstep; const char* b2 = last ? nB : cB + (size_t)(t + 2) * kstep;
            const char* a3 = a2 + kstep; const char* b3 = b2 + kstep;
            PG8_LDB(B0, 0, 0); PG8_SCHED; PG8_LDA(At, 0, 0); PG8_STAGE(PG8_SA(1, 1), a1 + hstepA, voffA);
            PG8_WAIT_L(8); PG8_BAR; PG8_WAIT_L(0); PG8_MMA(0, 0, At, B0); PG8_BAR; PG8_SCHED;
            PG8_LDB(B1, 0, 1); PG8_STAGE(PG8_SB(0, 0), b2, voffB);
            PG8_BAR; PG8_WAIT_L(0); PG8_MMA(0, 1, At, B1); PG8_BAR;
            PG8_LDA(At, 0, 1); PG8_STAGE(PG8_SA(0, 0), a2, voffA);
            PG8_BAR; PG8_WAIT_L(0); PG8_MMA(1, 0, At, B0); PG8_BAR; PG8_SCHED;
            PG8_STAGE(PG8_SB(0, 1), b2 + hstepB, voffB);
            PG8_WAIT_V(6); PG8_BAR; PG8_MMA(1, 1, At, B1); PG8_BAR;
            PG8_LDB(B0, 1, 0); PG8_SCHED; PG8_LDA(At, 1, 0); PG8_STAGE(PG8_SA(0, 1), a2 + hstepA, voffA);
            PG8_WAIT_L(8); PG8_BAR; PG8_WAIT_L(0); PG8_MMA(0, 0, At, B0); PG8_BAR; PG8_SCHED;
            PG8_LDB(B1, 1, 1); PG8_STAGE(PG8_SB(1, 0), b3, voffB);
            PG8_BAR; PG8_WAIT_L(0); PG8_MMA(0, 1, At, B1); PG8_BAR;
            PG8_LDA(At, 1, 1); PG8_STAGE(PG8_SA(1, 0), a3, voffA);
            PG8_BAR; PG8_WAIT_L(0); PG8_MMA(1, 0, At, B0); PG8_BAR; PG8_SCHED;
            PG8_STAGE(PG8_SB(1, 1), b3 + hstepB, voffB);
            PG8_WAIT_V(6); PG8_BAR; PG8_MMA(1, 1, At, B1); PG8_BAR;
        }
        E(acc, cur, wr, wc, fr, fq);
        if (!has_next) break;
#pragma unroll
        for (int a = 0; a < 2; ++a)
#pragma unroll
            for (int b = 0; b < 2; ++b)
#pragma unroll
                for (int m = 0; m < 4; ++m)
#pragma unroll
                    for (int n = 0; n < 2; ++n) acc[a][b][m][n] = (f32x4){0.f, 0.f, 0.f, 0.f};
        cur = nxt; cA = nA; cB = nB; ++ui;
    }
    PG8_WAIT_V(0);
    if (wr == 0) PG8_BAR;
    PG8_BAR;
#undef PG8_SA
#undef PG8_SB
#undef PG8_STAGE
#undef PG8_LDA
#undef PG8_LDB
#undef PG8_MMA
#undef PG8_WAIT_V
#undef PG8_WAIT_L
#undef PG8_BAR
#undef PG8_SCHED
}
}

#define EPI_ROW(u, ai, m) ((u).pm * 256 + (ai) * 128 + wr * 64 + (m) * 16 + fr)
#define EPI_COL(u, bj, n) ((u).pn * 256 + (bj) * 128 + wc * 32 + (n) * 16 + 4 * fq)

struct Epi1 {
    bf16_t* P; const float* rs; int pass; float* pshift; float* sshift; float* carry;
    __device__ __forceinline__ void operator()(const f32x4 (&acc)[2][2][4][2], const pg8::Unit& u, int wr, int wc, int fr, int fq) const {
#pragma unroll
        for (int ai = 0; ai < 2; ++ai)
#pragma unroll
            for (int m = 0; m < 4; ++m) {
                const int row = EPI_ROW(u, ai, m); const float s = rs[row];
                float* sdst = nullptr;
                if (pass == 0) { if ((row & 1023) == 1023) sdst = carry + (size_t)(row >> 10) * SHIFTC; }
                else { if (row < 8192) { if ((row & 1023) == 1023) sdst = pshift + (size_t)(row >> 10) * SHIFTC; } else { const int q = row - 8192; if ((q & 3) == 3) sdst = sshift + (size_t)(q >> 2) * SHIFTC; } }
                bf16_t* prow = P + (size_t)row * RWIN;
#pragma unroll
                for (int bj = 0; bj < 2; ++bj)
#pragma unroll
                    for (int n = 0; n < 2; ++n) {
                        const int col = EPI_COL(u, bj, n);
                        if (col < RWIN) {
                            const f32x4 v = acc[ai][bj][m][n] * s;
                            u32x2 o; o.x = pk2(v[0], v[1]); o.y = pk2(v[2], v[3]);
                            *(u32x2*)(prow + col) = o;
                            if (sdst && col < SHIFTC) *(f32x4*)(sdst + col) = v;
                        }
                    }
            }
    }
};
struct Epi2 {
    const float* xp; const float* xs; float* Y; bf16_t* XB; float* ss;
    __device__ __forceinline__ void operator()(const f32x4 (&acc)[2][2][4][2], const pg8::Unit& u, int wr, int wc, int fr, int fq) const {
#pragma unroll
        for (int ai = 0; ai < 2; ++ai)
#pragma unroll
            for (int m = 0; m < 4; ++m) {
                const int row = EPI_ROW(u, ai, m);
                const float* xr = row < MP ? xp + (size_t)row * D : xs + (size_t)(row - MP) * D;
                float part = 0.f;
#pragma unroll
                for (int bj = 0; bj < 2; ++bj)
#pragma unroll
                    for (int n = 0; n < 2; ++n) {
                        const int col = EPI_COL(u, bj, n);
                        const f32x4 v = acc[ai][bj][m][n] + *(const f32x4*)(xr + col);
                        *(f32x4*)(Y + (size_t)row * D + col) = v;
                        u32x2 o; o.x = pk2(v[0], v[1]); o.y = pk2(v[2], v[3]);
                        *(u32x2*)(XB + (size_t)row * D + col) = o;
                        part += (v[0] * v[0] + v[1] * v[1]) + (v[2] * v[2] + v[3] * v[3]);
                    }
                part += __shfl_xor(part, 16); part += __shfl_xor(part, 32);
                if (fq == 0) atomicAdd(ss + row, part);
            }
    }
};
struct Epi3 {
    bf16_t* P; const float* ss1; float* vsum; float* vsq;
    __device__ __forceinline__ void operator()(const f32x4 (&acc)[2][2][4][2], const pg8::Unit& u, int wr, int wc, int fr, int fq) const {
        const int region = u.pn >> 3;
#pragma unroll
        for (int ai = 0; ai < 2; ++ai)
#pragma unroll
            for (int m = 0; m < 4; ++m) {
                const int row = EPI_ROW(u, ai, m);
                const float s = rsqrtf(ss1[row] * (1.f / D) + 1e-6f);
                float p1 = 0.f, p2 = 0.f;
#pragma unroll
                for (int bj = 0; bj < 2; ++bj)
#pragma unroll
                    for (int n = 0; n < 2; ++n) {
                        const int col = EPI_COL(u, bj, n);
                        f32x4 v = acc[ai][bj][m][n] * s;
                        if (region == 2) { v[0] = v[0] * sigmoidf_(v[0]); v[1] = v[1] * sigmoidf_(v[1]); v[2] = v[2] * sigmoidf_(v[2]); v[3] = v[3] * sigmoidf_(v[3]); }
                        else { v[0] = gelu_tanh(v[0]); v[1] = gelu_tanh(v[1]); v[2] = gelu_tanh(v[2]); v[3] = gelu_tanh(v[3]); }
                        if (region == 1) { p1 += (v[0] + v[1]) + (v[2] + v[3]); p2 += (v[0] * v[0] + v[1] * v[1]) + (v[2] * v[2] + v[3] * v[3]); }
                        u32x2 o; o.x = pk2(v[0], v[1]); o.y = pk2(v[2], v[3]);
                        *(u32x2*)(P + (size_t)row * GMIN + col) = o;
                    }
                if (region == 1) {
                    p1 += __shfl_xor(p1, 16); p1 += __shfl_xor(p1, 32); p2 += __shfl_xor(p2, 16); p2 += __shfl_xor(p2, 32);
                    if (fq == 0) { atomicAdd(vsum + row, p1); atomicAdd(vsq + row, p2); }
                }
            }
    }
};
struct Epi4 {
    float* Y; float* ss;
    __device__ __forceinline__ void operator()(const f32x4 (&acc)[2][2][4][2], const pg8::Unit& u, int wr, int wc, int fr, int fq) const {
#pragma unroll
        for (int ai = 0; ai < 2; ++ai)
#pragma unroll
            for (int m = 0; m < 4; ++m) {
                const int row = EPI_ROW(u, ai, m);
                float part = 0.f;
#pragma unroll
                for (int bj = 0; bj < 2; ++bj)
#pragma unroll
                    for (int n = 0; n < 2; ++n) {
                        const int col = EPI_COL(u, bj, n);
                        float* yp = Y + (size_t)row * D + col;
                        const f32x4 v = acc[ai][bj][m][n] + *(const f32x4*)yp;
                        *(f32x4*)yp = v;
                        part += (v[0] * v[0] + v[1] * v[1]) + (v[2] * v[2] + v[3] * v[3]);
                    }
                part += __shfl_xor(part, 16); part += __shfl_xor(part, 32);
                if (fq == 0) atomicAdd(ss + row, part);
            }
    }
};

struct Frame {
    unsigned char* lds; int tid, lane, wave, G, bid;
    const float* const* in; float* out; unsigned char* ws; float* misc;
};

__device__ __forceinline__ void p0_transpose_item(const float* W, int K, int N, bf16_t* WT, const float* g, float* scr, int item, int lane) {
    const int nblk = N / 32, kb = item / nblk, nb = item % nblk, k0 = 64 * kb, n0 = 32 * nb;
#pragma unroll 8
    for (int i = 0; i < 32; ++i) { const int kk = 2 * i + (lane >> 5); float v = W[(size_t)(k0 + kk) * N + n0 + (lane & 31)]; if (g) v *= g[k0 + kk]; scr[kk * 33 + (lane & 31)] = v; }
    LDS_WAIT();
    const int c = lane & 7;
#pragma unroll
    for (int j = 0; j < 4; ++j) { const int n = (lane >> 3) + 8 * j; const float* s = scr + (8 * c) * 33 + n;
        u32x4 o; o.x = pk2(s[0 * 33], s[1 * 33]); o.y = pk2(s[2 * 33], s[3 * 33]); o.z = pk2(s[4 * 33], s[5 * 33]); o.w = pk2(s[6 * 33], s[7 * 33]);
        *(u32x4*)(WT + (size_t)(n0 + n) * K + k0 + 8 * c) = o; }
    LDS_WAIT();
}
__device__ __forceinline__ void phase_prologue(Frame& F) {
    float* scr = (float*)(F.lds + F.wave * 16384);
    const int gw = F.bid * NWAVES + F.wave, NGW = F.G * NWAVES;
    bf16_t* W1T = (bf16_t*)(F.ws + WS_W1T); bf16_t* W2T = (bf16_t*)(F.ws + WS_W2T); bf16_t* W3T = (bf16_t*)(F.ws + WS_W3T); bf16_t* W4T = (bf16_t*)(F.ws + WS_W4T);
    constexpr int I1 = (D / 64) * (RWIN / 32), I2 = (E / 64) * (D / 32), I3 = (D / 64) * (GMIN / 32), I4 = (E / 64) * (D / 32);
    for (int it = gw; it < I1 + I2 + I3 + I4; it += NGW) {
        int r = it;
        if (r < I1) { p0_transpose_item(F.in[6], D, RWIN, W1T, F.in[4], scr, r, F.lane); continue; } r -= I1;
        if (r < I2) { p0_transpose_item(F.in[17], E, D, W2T, nullptr, scr, r, F.lane); continue; } r -= I2;
        if (r < I3) { p0_transpose_item(F.in[18], D, GMIN, W3T, F.in[4] + D, scr, r, F.lane); continue; } r -= I3;
        p0_transpose_item(F.in[23], E, D, W4T, nullptr, scr, r, F.lane);
    }
    { u32x4* z = (u32x4*)(W1T + (size_t)RWIN * D); const int n = (RWIN_PAD - RWIN) * D * 2 / 16;
      for (int i = F.bid * NTHREADS + F.tid; i < n; i += F.G * NTHREADS) z[i] = (u32x4){0u, 0u, 0u, 0u};
      float* zs = F.misc + MI_SS1; for (int i = F.bid * NTHREADS + F.tid; i < 4 * MTOT; i += F.G * NTHREADS) zs[i] = 0.f; }
    bf16_t* XB = (bf16_t*)(F.out + OFF_SWKV);
    for (int gr = gw; gr < MTOT; gr += NGW) {
        const float* xr = gr < MP ? F.in[0] + (size_t)gr * D : F.in[1] + (size_t)(gr - MP) * D;
        int pmi;
        if (gr < MP) { const int b = gr >> 11, t = gr & 2047; pmi = t < 1024 ? b * 1024 + t : PA_ROWS + b * 1024 + (t - 1024); } else pmi = gr;
        const f32x4* x4 = (const f32x4*)xr + F.lane;
        f32x4 v[4]; float s = 0.f;
#pragma unroll
        for (int j = 0; j < 4; ++j) { v[j] = x4[64 * j]; s += (v[j][0] * v[j][0] + v[j][1] * v[j][1]) + (v[j][2] * v[j][2] + v[j][3] * v[j][3]); }
        s = wave_sum(s);
        u32x2* o = (u32x2*)(XB + (size_t)pmi * D) + F.lane;
#pragma unroll
        for (int j = 0; j < 4; ++j) { u32x2 w; w.x = pk2(v[j][0], v[j][1]); w.y = pk2(v[j][2], v[j][3]); o[64 * j] = w; }
        if (F.lane == 0) F.misc[MI_RS0 + pmi] = rsqrtf(s * (1.f / D) + 1e-6f);
    }
}

constexpr int TT = 32;
#define WKV_STEP(S, pW, pA, pB, pK, pR, vval, yout) do { \
    float sa0 = 0.f, sa1 = 0.f; \
    _Pragma("unroll") for (int k4 = 0; k4 < 16; ++k4) { const f32x4 a = ((const f32x4*)(pA))[k4]; sa0 += S[4 * k4] * a[0] + S[4 * k4 + 2] * a[2]; sa1 += S[4 * k4 + 1] * a[1] + S[4 * k4 + 3] * a[3]; } \
    const float sa = sa0 + sa1; float y0 = 0.f, y1 = 0.f; \
    _Pragma("unroll") for (int k4 = 0; k4 < 16; ++k4) { const f32x4 w = ((const f32x4*)(pW))[k4], bb = ((const f32x4*)(pB))[k4], kk = ((const f32x4*)(pK))[k4], rr = ((const f32x4*)(pR))[k4]; \
        _Pragma("unroll") for (int e = 0; e < 4; ++e) { float s = S[4 * k4 + e] * w[e] + sa * bb[e] + (vval) * kk[e]; S[4 * k4 + e] = s; if (e & 1) y1 += s * rr[e]; else y0 += s * rr[e]; } } \
    (yout) = y0 + y1; } while (0)

__device__ __forceinline__ void scan_prompt(Frame& F, int pass) {
    float* L = (float*)F.lds;
    float* W2H = L; float* A2H = L + 4096; float* PAR = L + 8192;
    float* TW = L + 9216; float* TA = TW + 2048; float* VW = TA + 2048; float* VA = VW + 2048; float* VB = VA + 2048; float* VK = VB + 2048; float* VR = VK + 2048; float* VV = VR + 2048; float* VY = VV + 2048; float* BON = VY + 2048;
    const bf16_t* P = (const bf16_t*)(F.ws + WS_PROJH);
    bf16_t* O = (bf16_t*)(F.ws + WS_O);
    const float* carry = F.misc + MI_CARRY;
    float* pwkv = F.out + OFF_PWKV;
    const int lane = F.lane, tid = F.tid;
    for (int u = F.bid; u < 256; u += F.G) {
        const int b = u >> 5, h = u & 31, hc = h * 64;
        __syncthreads();
        for (int idx = tid; idx < 4096; idx += NTHREADS) { const int j = idx >> 6, c = idx & 63; W2H[idx] = F.in[9][(size_t)j * E + hc + c]; A2H[idx] = F.in[11][(size_t)j * E + hc + c]; }
        if (tid < 64) { const int c = tid;
            PAR[0 * 64 + c] = F.in[7][hc + c]; PAR[1 * 64 + c] = F.in[7][E + hc + c]; PAR[2 * 64 + c] = F.in[7][2 * E + hc + c]; PAR[3 * 64 + c] = F.in[7][3 * E + c]; PAR[4 * 64 + c] = F.in[7][3 * E + 64 + c];
            PAR[5 * 64 + c] = F.in[8][hc + c]; PAR[6 * 64 + c] = F.in[10][hc + c]; PAR[7 * 64 + c] = F.in[12][hc + c]; PAR[8 * 64 + c] = F.in[13][hc + c]; PAR[9 * 64 + c] = F.in[14][hc + c];
            PAR[10 * 64 + c] = F.in[15][hc + c]; PAR[11 * 64 + c] = F.in[16][hc + c]; }
        float S[64];
        if (pass == 0) {
#pragma unroll
            for (int k = 0; k < 64; ++k) S[k] = 0.f;
        } else {
            const f32x4* sp = (const f32x4*)(pwkv + ((size_t)(b * NH + h) * 64 + lane) * 64);
#pragma unroll
            for (int k4 = 0; k4 < 16; ++k4) { const f32x4 v = sp[k4]; S[4 * k4] = v[0]; S[4 * k4 + 1] = v[1]; S[4 * k4 + 2] = v[2]; S[4 * k4 + 3] = v[3]; }
        }
        __syncthreads();
#pragma unroll 1
        for (int c0 = 0; c0 < 1024; c0 += TT) {
            const int prow0 = b * 1024 + c0;
#pragma unroll
            for (int i = 0; i < TT * 64 / NTHREADS; ++i) {
                const int tl = (tid >> 6) + NWAVES * i, c = lane;
                const bf16_t* pr = P + (size_t)(prow0 + tl) * RWIN;
                const float sr = bf2f(pr[hc + c]), sk = bf2f(pr[E + hc + c]), sv = bf2f(pr[2 * E + hc + c]), swd = bf2f(pr[3 * E + c]), sad = bf2f(pr[3 * E + 64 + c]);
                float qr, qk, qv, qwd, qad;
                if (c0 + tl > 0) { const bf16_t* pp = pr - RWIN; qr = bf2f(pp[hc + c]); qk = bf2f(pp[E + hc + c]); qv = bf2f(pp[2 * E + hc + c]); qwd = bf2f(pp[3 * E + c]); qad = bf2f(pp[3 * E + 64 + c]); }
                else if (pass == 0) { qr = qk = qv = qwd = qad = 0.f; }
                else { const float* cr = carry + (size_t)b * SHIFTC; qr = cr[hc + c]; qk = cr[E + hc + c]; qv = cr[2 * E + hc + c]; qwd = cr[3 * E + c]; qad = cr[3 * E + 64 + c]; }
                VR[tl * 64 + c] = sr + (qr - sr) * PAR[c]; VK[tl * 64 + c] = sk + (qk - sk) * PAR[64 + c]; VV[tl * 64 + c] = sv + (qv - sv) * PAR[128 + c];
                TW[tl * 64 + c] = tanhf(swd + (qwd - swd) * PAR[192 + c]); TA[tl * 64 + c] = sad + (qad - sad) * PAR[256 + c];
            }
            __syncthreads();
#pragma unroll 1
            for (int i = 0; i < TT * 64 / NTHREADS; ++i) {
                const int tl = (tid >> 6) + NWAVES * i, c = lane;
                float wf = PAR[5 * 64 + c], af = PAR[6 * 64 + c];
                const f32x4* tw4 = (const f32x4*)(TW + tl * 64); const f32x4* ta4 = (const f32x4*)(TA + tl * 64);
#pragma unroll 4
                for (int j4 = 0; j4 < 16; ++j4) { const f32x4 a = tw4[j4], d = ta4[j4];
#pragma unroll
                    for (int e = 0; e < 4; ++e) { wf += a[e] * W2H[(4 * j4 + e) * 64 + c]; af += d[e] * A2H[(4 * j4 + e) * 64 + c]; } }
                const float dec = __expf(-0.6065306597126334f * sigmoidf_(wf));
                const float av = sigmoidf_(af);
                const float kraw = VK[tl * 64 + c], rv = VR[tl * 64 + c];
                float kk = kraw * PAR[7 * 64 + c];
                const float nrm = wave_sum(kk * kk);
                kk = kk / fmaxf(sqrtf(nrm), 1e-12f);
                const float kp = kraw * (1.f + (av - 1.f) * PAR[8 * 64 + c]);
                const float bon = wave_sum(rv * kp * PAR[9 * 64 + c]);
                VW[tl * 64 + c] = dec; VA[tl * 64 + c] = -kk; VB[tl * 64 + c] = kk * av; VK[tl * 64 + c] = kp;
                if (c == 0) BON[tl] = bon;
            }
            __syncthreads();
            if (F.wave == 0) {
#pragma unroll 1
                for (int tl = 0; tl < TT; ++tl) {
                    const float vv = VV[tl * 64 + lane]; float y;
                    WKV_STEP(S, VW + tl * 64, VA + tl * 64, VB + tl * 64, VK + tl * 64, VR + tl * 64, vv, y);
                    VY[tl * 64 + lane] = y;
                }
            }
            __syncthreads();
#pragma unroll
            for (int i = 0; i < TT * 64 / NTHREADS; ++i) {
                const int tl = (tid >> 6) + NWAVES * i, c = lane;
                const float y = VY[tl * 64 + c];
                const float mean = wave_sum(y) * (1.f / 64.f); const float dy = y - mean;
                const float var = wave_sum(dy * dy) * (1.f / 64.f);
                const float yn = dy * rsqrtf(var + 64e-5f) * PAR[10 * 64 + c] + PAR[11 * 64 + c];
                const float z = bf2f(P[(size_t)(prow0 + tl) * RWIN + SHIFTC + hc + c]);
                const float o = (yn + BON[tl] * VV[tl * 64 + c]) * (z * sigmoidf_(z));
                const int grow = b * 2048 + pass * 1024 + c0 + tl;
                const float o2 = __shfl_down(o, 1);
                if (!(c & 1)) *(unsigned*)(O + (size_t)grow * E + hc + c) = pk2(o, o2);
            }
            __syncthreads();
        }
        if (F.wave == 0) {
            f32x4* sp = (f32x4*)(pwkv + ((size_t)(b * NH + h) * 64 + lane) * 64);
#pragma unroll
            for (int k4 = 0; k4 < 16; ++k4) sp[k4] = (f32x4){S[4 * k4], S[4 * k4 + 1], S[4 * k4 + 2], S[4 * k4 + 3]};
        }
    }
    __syncthreads();
}

__device__ __forceinline__ void scan_samples(Frame& F) {
    float* scr = (float*)F.lds + F.wave * 2560;
    float* TW = scr; float* TA = scr + 256; float* VW = scr + 512; float* VA = scr + 768; float* VB = scr + 1024; float* VK = scr + 1280; float* VR = scr + 1536; float* VV = scr + 1792; float* VY = scr + 2048; float* BON = scr + 2304;
    const bf16_t* P = (const bf16_t*)(F.ws + WS_PROJH);
    bf16_t* O = (bf16_t*)(F.ws + WS_O);
    const int c = F.lane;
    const int gw = F.bid * NWAVES + F.wave, NGW = F.G * NWAVES;
    for (int su = gw; su < 128 * NH; su += NGW) {
        const int sb = su >> 5, h = su & 31, hc = h * 64;
        const float mur = F.in[7][hc + c], muk = F.in[7][E + hc + c], muv = F.in[7][2 * E + hc + c], muwd = F.in[7][3 * E + c], muad = F.in[7][3 * E + 64 + c];
        const float* st = F.in[2] + (size_t)sb * SHIFTC;
        float qr = st[hc + c], qk = st[E + hc + c], qv = st[2 * E + hc + c], qwd = st[3 * E + c], qad = st[3 * E + 64 + c];
        float r[4], k[4], v[4];
        LDS_WAIT();
#pragma unroll
        for (int tl = 0; tl < 4; ++tl) {
            const bf16_t* pr = P + (size_t)(PA_ROWS + sb * 4 + tl) * RWIN;
            const float sr = bf2f(pr[hc + c]), sk = bf2f(pr[E + hc + c]), sv = bf2f(pr[2 * E + hc + c]), swd = bf2f(pr[3 * E + c]), sad = bf2f(pr[3 * E + 64 + c]);
            r[tl] = sr + (qr - sr) * mur; k[tl] = sk + (qk - sk) * muk; v[tl] = sv + (qv - sv) * muv;
            TW[tl * 64 + c] = tanhf(swd + (qwd - swd) * muwd); TA[tl * 64 + c] = sad + (qad - sad) * muad;
            qr = sr; qk = sk; qv = sv; qwd = swd; qad = sad;
        }
        LDS_WAIT();
        float wf[4], af[4];
        { const float w0 = F.in[8][hc + c], a0 = F.in[10][hc + c];
#pragma unroll
          for (int tl = 0; tl < 4; ++tl) { wf[tl] = w0; af[tl] = a0; } }
#pragma unroll 4
        for (int j = 0; j < 64; ++j) {
            const float w2 = F.in[9][(size_t)j * E + hc + c], a2 = F.in[11][(size_t)j * E + hc + c];
#pragma unroll
            for (int tl = 0; tl < 4; ++tl) { wf[tl] += TW[tl * 64 + j] * w2; af[tl] += TA[tl * 64 + j] * a2; }
        }
        const float kkp = F.in[12][hc + c], kap = F.in[13][hc + c], rkp = F.in[14][hc + c];
#pragma unroll
        for (int tl = 0; tl < 4; ++tl) {
            const float dec = __expf(-0.6065306597126334f * sigmoidf_(wf[tl]));
            const float av = sigmoidf_(af[tl]);
            float kk = k[tl] * kkp;
            const float nrm = wave_sum(kk * kk);
            kk = kk / fmaxf(sqrtf(nrm), 1e-12f);
            const float kp = k[tl] * (1.f + (av - 1.f) * kap);
            const float bon = wave_sum(r[tl] * kp * rkp);
            VW[tl * 64 + c] = dec; VA[tl * 64 + c] = -kk; VB[tl * 64 + c] = kk * av; VK[tl * 64 + c] = kp; VR[tl * 64 + c] = r[tl]; VV[tl * 64 + c] = v[tl];
            if (c == 0) BON[tl] = bon;
        }
        LDS_WAIT();
        float S[64];
        { const f32x4* sp = (const f32x4*)(F.in[3] + ((size_t)(sb * NH + h) * 64 + c) * 64);
#pragma unroll
          for (int k4 = 0; k4 < 16; ++k4) { const f32x4 t = sp[k4]; S[4 * k4] = t[0]; S[4 * k4 + 1] = t[1]; S[4 * k4 + 2] = t[2]; S[4 * k4 + 3] = t[3]; } }
#pragma unroll 1
        for (int tl = 0; tl < 4; ++tl) { const float vv = VV[tl * 64 + c]; float y; WKV_STEP(S, VW + tl * 64, VA + tl * 64, VB + tl * 64, VK + tl * 64, VR + tl * 64, vv, y); VY[tl * 64 + c] = y; }
        { f32x4* sp = (f32x4*)(F.out + OFF_SWKV + ((size_t)(sb * NH + h) * 64 + c) * 64);
#pragma unroll
          for (int k4 = 0; k4 < 16; ++k4) sp[k4] = (f32x4){S[4 * k4], S[4 * k4 + 1], S[4 * k4 + 2], S[4 * k4 + 3]}; }
        const float lng = F.in[15][hc + c], lnb = F.in[16][hc + c];
        LDS_WAIT();
#pragma unroll 1
        for (int tl = 0; tl < 4; ++tl) {
            const float yv = VY[tl * 64 + c];
            const float mean = wave_sum(yv) * (1.f / 64.f); const float dy = yv - mean;
            const float var = wave_sum(dy * dy) * (1.f / 64.f);
            const float yn = dy * rsqrtf(var + 64e-5f) * lng + lnb;
            const float z = bf2f(P[(size_t)(PA_ROWS + sb * 4 + tl) * RWIN + SHIFTC + hc + c]);
            const float o = (yn + BON[tl] * VV[tl * 64 + c]) * (z * sigmoidf_(z));
            const float o2 = __shfl_down(o, 1);
            if (!(c & 1)) *(unsigned*)(O + (size_t)(MP + sb * 4 + tl) * E + hc + c) = pk2(o, o2);
        }
    }
}

constexpr int GP = 136;
__device__ __forceinline__ void phase_gate(Frame& F) {
    bf16_t* P2 = (bf16_t*)(F.ws + WS_PROJ2);
    const float* vsum = F.misc + MI_VSUM; const float* vsq = F.misc + MI_VSQ;
    bf16_t* WM = (bf16_t*)F.lds; bf16_t* VT = WM + 128 * GP;
    const int tid = F.tid, lane = F.lane, fr = lane & 15, fq = lane >> 4;
    for (int u = F.bid; u < 1024; u += F.G) {
        const int bc = u >> 3, g = u & 7, row0 = bc * 128;
        __syncthreads();
        for (int idx = tid; idx < 128 * 32; idx += NTHREADS) { const int t = idx >> 5, s4 = (idx & 31) * 4;
            const f32x4 w = *(const f32x4*)(F.in[21] + ((size_t)g * 128 + t) * 128 + s4);
            u32x2 o; o.x = pk2(s4 <= t ? w[0] : 0.f, s4 + 1 <= t ? w[1] : 0.f); o.y = pk2(s4 + 2 <= t ? w[2] : 0.f, s4 + 3 <= t ? w[3] : 0.f);
            *(u32x2*)(WM + t * GP + s4) = o; }
        for (int idx = tid; idx < 128 * 32; idx += NTHREADS) { const int s = idx >> 5, d8 = (idx & 31) * 8, row = row0 + s;
            const float mean = vsum[row] * (1.f / E); const float rstd = rsqrtf(vsq[row] * (1.f / E) - mean * mean + 1e-5f);
            const u32x4 raw = *(const u32x4*)(P2 + (size_t)row * GMIN + E + g * 256 + d8);
            const float* vg = F.in[19] + g * 256 + d8; const float* vb = F.in[20] + g * 256 + d8;
            float x[8] = {bflo(raw.x), bfhi(raw.x), bflo(raw.y), bfhi(raw.y), bflo(raw.z), bfhi(raw.z), bflo(raw.w), bfhi(raw.w)};
#pragma unroll
            for (int e = 0; e < 8; ++e) { const float vn = (x[e] - mean) * rstd * vg[e] + vb[e]; VT[(d8 + e) * GP + s] = (bf16_t)(pk2(vn, 0.f) & 0xffffu); } }
        __syncthreads();
        const int t0 = F.wave * 16;
        f32x4 acc[16];
#pragma unroll
        for (int i = 0; i < 16; ++i) acc[i] = (f32x4){0.f, 0.f, 0.f, 0.f};
        const int nkb = (t0 + 15) / 32 + 1;
        for (int kb = 0; kb < nkb; ++kb) {
            const bf16x8 yf = *(const bf16x8*)(WM + (t0 + fr) * GP + kb * 32 + fq * 8);
#pragma unroll
            for (int dt = 0; dt < 16; ++dt) { const bf16x8 xf = *(const bf16x8*)(VT + (dt * 16 + fr) * GP + kb * 32 + fq * 8);
                acc[dt] = __builtin_amdgcn_mfma_f32_16x16x32_bf16(xf, yf, acc[dt], 0, 0, 0); }
        }
        const int t = t0 + fr, row = row0 + t; const float bias = F.in[22][g * 128 + t];
        bf16_t* prow = P2 + (size_t)row * GMIN + g * 256;
#pragma unroll
        for (int dt = 0; dt < 16; ++dt) { const int d = dt * 16 + 4 * fq;
            const u32x2 uu = *(const u32x2*)(prow + d); const u32x2 zz = *(const u32x2*)(prow + 2 * E + d);
            const float o0 = bflo(uu.x) * (acc[dt][0] + bias) * bflo(zz.x), o1 = bfhi(uu.x) * (acc[dt][1] + bias) * bfhi(zz.x);
            const float o2 = bflo(uu.y) * (acc[dt][2] + bias) * bflo(zz.y), o3 = bfhi(uu.y) * (acc[dt][3] + bias) * bfhi(zz.y);
            u32x2 o; o.x = pk2(o0, o1); o.y = pk2(o2, o3); *(u32x2*)(prow + d) = o; }
    }
    float* sv = F.out + OFF_SV;
    for (int it = F.bid * NTHREADS + tid; it < 128 * E; it += F.G * NTHREADS) {
        const int sb = it >> 11, col = it & 2047, g = col >> 8;
        const float vg = F.in[19][col], vb = F.in[20][col];
        float vn[4];
#pragma unroll
        for (int t = 0; t < 4; ++t) { const int row = MP + sb * 4 + t; const float mean = vsum[row] * (1.f / E); const float rstd = rsqrtf(vsq[row] * (1.f / E) - mean * mean + 1e-5f);
            vn[t] = (bf2f(P2[(size_t)row * GMIN + E + col]) - mean) * rstd * vg + vb; sv[((size_t)sb * 4 + t) * E + col] = vn[t]; }
#pragma unroll
        for (int t = 0; t < 4; ++t) { const int row = MP + sb * 4 + t; float mx = F.in[22][g * 128 + t];
#pragma unroll
            for (int s = 0; s <= t; ++s) mx += F.in[21][((size_t)g * 128 + t) * 128 + s] * vn[s];
            bf16_t* pu = P2 + (size_t)row * GMIN + col; const float o = bf2f(pu[0]) * mx * bf2f(pu[2 * E]);
            pu[0] = (bf16_t)(pk2(o, 0.f) & 0xffffu); }
    }
}

__device__ __forceinline__ void phase_final(Frame& F) {
    const float* ss2 = F.misc + MI_SS2; const float* gf = F.in[5];
    const int gw = F.bid * NWAVES + F.wave, NGW = F.G * NWAVES;
    f32x4 gv[4];
#pragma unroll
    for (int j = 0; j < 4; ++j) gv[j] = ((const f32x4*)gf)[F.lane + 64 * j];
    for (int row = gw; row < MTOT; row += NGW) {
        const float s = rsqrtf(ss2[row] * (1.f / D) + 1e-6f);
        f32x4* y = (f32x4*)(F.out + OFF_Y + (size_t)row * D) + F.lane;
#pragma unroll
        for (int j = 0; j < 4; ++j) { f32x4 v = y[64 * j]; v = v * s * gv[j]; y[64 * j] = v; }
    }
}

__global__ void __launch_bounds__(NTHREADS, 2) fwd_kernel(Params p) {
    extern __shared__ __attribute__((aligned(16))) unsigned char lds[];
    Frame F;
    F.lds = lds; F.tid = threadIdx.x; F.lane = F.tid & 63; F.wave = __builtin_amdgcn_readfirstlane(F.tid >> 6); F.G = gridDim.x; F.bid = blockIdx.x;
    F.in = p.in; F.out = p.out; F.ws = p.ws; F.misc = (float*)(p.ws + WS_MISC);
    const int lo = p.ph_lo, hi = p.ph_hi;
#ifndef PHASE_MASK
#define PHASE_MASK 0x3ff
#endif
#define IN(k) (((PHASE_MASK >> (k)) & 1) && lo <= (k) && (k) < hi)
#define SEAM(k) do { if (IN(k) && IN((k) + 1)) { __threadfence(); cg::this_grid().sync(); } } while (0)
    bf16_t* XB = (bf16_t*)(F.out + OFF_SWKV);
    bf16_t* PROJH = (bf16_t*)(F.ws + WS_PROJH);
    if (IN(0)) { phase_prologue(F); }
    SEAM(0);
    if (IN(1)) {
        pg8::Gemm g{XB, (const bf16_t*)(F.ws + WS_W1T), PA_ROWS, RWIN_PAD, D, D}; pg8::StaticOrder S; S.init(PA_ROWS, RWIN_PAD, F.G, F.bid);
        Epi1 E1{PROJH, F.misc + MI_RS0, 0, F.out + OFF_PSHIFT, F.out + OFF_SSHIFT, F.misc + MI_CARRY};
        pg8::gemm_phase<Epi1>((LAS unsigned char*)lds, g, S, E1);
    }
    SEAM(1);
    if (IN(2)) { scan_prompt(F, 0); }
    SEAM(2);
    if (IN(3)) {
        pg8::Gemm g{XB + (size_t)PA_ROWS * D, (const bf16_t*)(F.ws + WS_W1T), PB_ROWS, RWIN_PAD, D, D}; pg8::StaticOrder S; S.init(PB_ROWS, RWIN_PAD, F.G, F.bid);
        Epi1 E1{PROJH, F.misc + MI_RS0 + PA_ROWS, 1, F.out + OFF_PSHIFT, F.out + OFF_SSHIFT, F.misc + MI_CARRY};
        pg8::gemm_phase<Epi1>((LAS unsigned char*)lds, g, S, E1);
    }
    SEAM(3);
    if (IN(4)) { scan_prompt(F, 1); scan_samples(F); }
    SEAM(4);
    if (IN(5)) {
        pg8::Gemm g{(const bf16_t*)(F.ws + WS_O), (const bf16_t*)(F.ws + WS_W2T), MTOT, D, E, E}; pg8::StaticOrder S; S.init(MTOT, D, F.G, F.bid);
        Epi2 E2{F.in[0], F.in[1], F.out + OFF_Y, (bf16_t*)(F.ws + WS_X1B), F.misc + MI_SS1};
        pg8::gemm_phase<Epi2>((LAS unsigned char*)lds, g, S, E2);
    }
    SEAM(5);
    if (IN(6)) {
        pg8::Gemm g{(const bf16_t*)(F.ws + WS_X1B), (const bf16_t*)(F.ws + WS_W3T), MTOT, GMIN, D, D}; pg8::StaticOrder S; S.init(MTOT, GMIN, F.G, F.bid);
        Epi3 E3{(bf16_t*)(F.ws + WS_PROJ2), F.misc + MI_SS1, F.misc + MI_VSUM, F.misc + MI_VSQ};
        pg8::gemm_phase<Epi3>((LAS unsigned char*)lds, g, S, E3);
    }
    SEAM(6);
    if (IN(7)) { phase_gate(F); }
    SEAM(7);
    if (IN(8)) {
        pg8::Gemm g{(const bf16_t*)(F.ws + WS_PROJ2), (const bf16_t*)(F.ws + WS_W4T), MTOT, D, E, GMIN}; pg8::StaticOrder S; S.init(MTOT, D, F.G, F.bid);
        Epi4 E4{F.out + OFF_Y, F.misc + MI_SS2};
        pg8::gemm_phase<Epi4>((LAS unsigned char*)lds, g, S, E4);
    }
    SEAM(8);
    if (IN(9)) { phase_final(F); }
#undef IN
#undef SEAM
}

constexpr int NPHASES = 10;
extern "C" void kernel_launch(void* const* d_in, const int* in_sizes, int n_in, void* d_out, int out_size, void* d_ws, size_t ws_size, hipStream_t stream) {
    static int grid = 0;
    if (grid == 0) {
        int dev = 0, cus = 0, per_cu = 0;
        hipGetDevice(&dev);
        hipDeviceGetAttribute(&cus, hipDeviceAttributeMultiprocessorCount, dev);
        hipFuncSetAttribute((const void*)fwd_kernel, hipFuncAttributeMaxDynamicSharedMemorySize, LDS_BYTES);
        hipOccupancyMaxActiveBlocksPerMultiprocessor(&per_cu, (const void*)fwd_kernel, NTHREADS, LDS_BYTES);
        if (per_cu < 1) per_cu = 1;
        grid = cus * per_cu;
        if (grid > 256) grid = 256;
        (void)hipGetLastError();
    }
    Params p{};
    for (int i = 0; i < 24; ++i) p.in[i] = (const float*)d_in[i];
    p.out = (float*)d_out; p.ws = (unsigned char*)d_ws;
#if MK_ONE_LAUNCH
    p.ph_lo = 0; p.ph_hi = NPHASES;
    void* args[] = {&p};
    hipError_t e = hipLaunchCooperativeKernel((const void*)fwd_kernel, dim3(grid), dim3(NTHREADS), args, LDS_BYTES, stream);
    if (e != hipSuccess) fprintf(stderr, "cooperative launch failed: %s (grid %d)\n", hipGetErrorString(e), grid);
#else
    for (int ph = 0; ph < NPHASES; ++ph) {
        p.ph_lo = ph; p.ph_hi = ph + 1;
        hipLaunchKernelGGL(fwd_kernel, dim3(grid), dim3(NTHREADS), LDS_BYTES, stream, p);
    }
#endif
}
```

```cpp
#include <hip/hip_runtime.h>
#include <hip/hip_cooperative_groups.h>
#include <cstdio>
namespace cg = cooperative_groups;

#ifndef MK_ONE_LAUNCH
#define MK_ONE_LAUNCH 1
#endif

#define LAS __attribute__((address_space(3)))
typedef unsigned short bf16_t;
typedef short bf16x8 __attribute__((ext_vector_type(8)));
typedef float f32x4 __attribute__((ext_vector_type(4)));
typedef unsigned u32x2 __attribute__((ext_vector_type(2)));
typedef unsigned u32x4 __attribute__((ext_vector_type(4)));

constexpr int D = 1024, E = 2048, NH = 32, SHIFTC = 6272, RWIN = 8320, RWIN_PAD = 8448, GMIN = 6144;
constexpr int MP = 16384, MS = 512, MTOT = 16896;
constexpr int PA_ROWS = 8192, PB_ROWS = 8704;
constexpr int NTHREADS = 512, NWAVES = 8;
constexpr int LDS_BYTES = 160768;
constexpr size_t OFF_Y = 0, OFF_PSHIFT = 17301504, OFF_PWKV = 17351680, OFF_SSHIFT = 18400256, OFF_SWKV = 19203072, OFF_SV = 35980288;
constexpr size_t MiB = 1u << 20;
constexpr size_t WS_O = 0, WS_PROJH = 66 * MiB, WS_W1T = 204 * MiB + 512 * 1024, WS_X1B = 198 * MiB, WS_PROJ2 = 0;
constexpr size_t WS_BAR = 255 * MiB;
constexpr size_t WS_W3T = 231 * MiB, WS_W4T = 243 * MiB, WS_W2T = 247 * MiB, WS_MISC = 251 * MiB;
constexpr int MI_RS0 = 0, MI_SS1 = 16896, MI_VSUM = 2 * 16896, MI_VSQ = 3 * 16896, MI_SS2 = 4 * 16896, MI_CARRY = 5 * 16896;

struct Params { const float* in[24]; float* out; unsigned char* ws; int ph_lo, ph_hi; };

__device__ __forceinline__ unsigned pk2(float lo, float hi) { unsigned r; asm("v_cvt_pk_bf16_f32 %0, %1, %2" : "=v"(r) : "v"(lo), "v"(hi)); return r; }
__device__ __forceinline__ float bf2f(bf16_t b) { return __uint_as_float(((unsigned)b) << 16); }
__device__ __forceinline__ float bflo(unsigned u) { return __uint_as_float(u << 16); }
__device__ __forceinline__ float bfhi(unsigned u) { return __uint_as_float(u & 0xffff0000u); }
__device__ __forceinline__ float dpp_f(float v, const int ctrl_sel) {
    int r;
    if (ctrl_sel == 0) r = __builtin_amdgcn_update_dpp(0, __float_as_int(v), 0xB1, 0xf, 0xf, true);
    else if (ctrl_sel == 1) r = __builtin_amdgcn_update_dpp(0, __float_as_int(v), 0x4E, 0xf, 0xf, true);
    else if (ctrl_sel == 2) r = __builtin_amdgcn_update_dpp(0, __float_as_int(v), 0x141, 0xf, 0xf, true);
    else r = __builtin_amdgcn_update_dpp(0, __float_as_int(v), 0x140, 0xf, 0xf, true);
    return __int_as_float(r);
}
__device__ __forceinline__ float wave_sum(float v) {
    v += dpp_f(v, 0); v += dpp_f(v, 1); v += dpp_f(v, 2); v += dpp_f(v, 3);
    const int iv = __float_as_int(v);
    const float a = __int_as_float(__builtin_amdgcn_readlane(iv, 0)), b = __int_as_float(__builtin_amdgcn_readlane(iv, 16));
    const float c = __int_as_float(__builtin_amdgcn_readlane(iv, 32)), d = __int_as_float(__builtin_amdgcn_readlane(iv, 48));
    return (a + b) + (c + d);
}
#define LBAR() do { asm volatile("s_waitcnt lgkmcnt(0)" ::: "memory"); __builtin_amdgcn_s_barrier(); asm volatile("" ::: "memory"); } while (0)
__device__ __forceinline__ float rcp_(float x) { return __builtin_amdgcn_rcpf(x); }
__device__ __forceinline__ float sigmoidf_(float x) { return rcp_(1.f + __expf(-x)); }
__device__ __forceinline__ float tanh_(float x) { return 1.f - 2.f * rcp_(1.f + __expf(2.f * x)); }
__device__ __forceinline__ float gelu_tanh(float x) { const float u = 1.5957691216057308f * (x + 0.044715f * x * x * x); return x * rcp_(1.f + __expf(-u)); }
#define LDS_WAIT() asm volatile("s_waitcnt lgkmcnt(0)" ::: "memory")

namespace pg8 {
constexpr int BM = 256, BK = 64, HALF = 128, HTB = HALF * BK * 2, STAGE_BYTES = 8 * HTB, NXCD = 8, WGM = 8;
__host__ __device__ __forceinline__ int lds_byte(int r, int c) { const int st = (r >> 4) * 2 + (c >> 5), rr = r & 15, cc = c & 31, ob = rr * 64 + cc * 2; return st * 1024 + (ob ^ (((ob >> 9) & 1) << 5)); }
__host__ __device__ __forceinline__ void stage_rc(int b, int& R, int& C) { const int st = b / 1024, sb = b % 1024, swz = sb ^ (((sb >> 9) & 1) << 5); R = (st >> 1) * 16 + swz / 64; C = (st & 1) * 32 + (swz % 64) / 2; }
struct Unit { int pm, pn; };
struct Gemm { const bf16_t* A; const bf16_t* Bt; int M, N, K, lda; };
struct StaticOrder {
    int nM, nN, nwg, G, c;
    __device__ void init(int M, int N, int G_, int c_) { nM = M / BM; nN = N / BM; nwg = nM * nN; G = G_; c = c_; }
    __device__ bool next(int i, Unit& u) const {
        const long L = (long)i * G + c; if (L >= nwg) return false;
        int wgid = (int)L; { const int q = nwg / NXCD, r = nwg % NXCD, xcd = wgid % NXCD, off = wgid / NXCD; wgid = (xcd < r ? xcd * (q + 1) : r * (q + 1) + (xcd - r) * q) + off; }
        const int nig = WGM * nN, gid = wgid / nig, fm = gid * WGM, gsz = (nM - fm) < WGM ? (nM - fm) : WGM;
        u.pm = fm + ((wgid % nig) % gsz); u.pn = (wgid % nig) / gsz; return true;
    }
};
template <class Epi>
__device__ __forceinline__ void gemm_phase(LAS unsigned char* lds, const Gemm g, const StaticOrder& S, const Epi& E) {
    const int tid = threadIdx.x, wid = __builtin_amdgcn_readfirstlane(tid >> 6), lane = tid & 63, wr = wid >> 2, wc = wid & 3, fr = lane & 15, fq = lane >> 4;
    const int K = g.K, nt = K / BK, lda = g.lda;
    unsigned voffA[2], voffB[2];
#pragma unroll
    for (int i = 0; i < 2; ++i) { int R, C; stage_rc(tid * 16 + i * 8192, R, C); voffA[i] = (unsigned)(R * lda + C) * 2u; voffB[i] = (unsigned)(R * K + C) * 2u; }
    const size_t kstep = (size_t)(BK * 2);
    const size_t hstepA = (size_t)HALF * lda * 2, hstepB = (size_t)HALF * K * 2;
    const size_t tstepA = 2 * hstepA, tstepB = 2 * hstepB;
    const unsigned ldsw = (unsigned)wid * 1024u;
    const int aoff = lds_byte(wr * 64 + fr, fq * 8), boff = lds_byte(wc * 32 + fr, fq * 8);
#define PG8_SA(b, h) (((b) * 2 + (h)) * HTB)
#define PG8_SB(b, h) ((4 + (b) * 2 + (h)) * HTB)
#define PG8_STAGE(bufoff, gbase, voff) do { _Pragma("unroll") for (int _i = 0; _i < 2; ++_i) \
        __builtin_amdgcn_global_load_lds((const unsigned*)((const char*)(gbase) + (voff)[_i]), (LAS unsigned*)(lds + (bufoff) + ldsw + _i * 8192), 16, 0, 0); } while (0)
#define PG8_LDA(dst, b, h) do { _Pragma("unroll") for (int m = 0; m < 4; ++m) _Pragma("unroll") for (int k = 0; k < 2; ++k) dst[m][k] = *(const LAS bf16x8*)(lds + PG8_SA(b, h) + aoff + m * 2048 + k * 1024); } while (0)
#define PG8_LDB(dst, b, h) do { _Pragma("unroll") for (int n = 0; n < 2; ++n) _Pragma("unroll") for (int k = 0; k < 2; ++k) dst[n][k] = *(const LAS bf16x8*)(lds + PG8_SB(b, h) + boff + n * 2048 + k * 1024); } while (0)
#define PG8_MMA(ai, bj, At, Bt) do { __builtin_amdgcn_s_setprio(1); _Pragma("unroll") for (int m = 0; m < 4; ++m) _Pragma("unroll") for (int n = 0; n < 2; ++n) _Pragma("unroll") for (int k = 0; k < 2; ++k) \
        acc[ai][bj][m][n] = __builtin_amdgcn_mfma_f32_16x16x32_bf16(Bt[n][k], At[m][k], acc[ai][bj][m][n], 0, 0, 0); __builtin_amdgcn_s_setprio(0); } while (0)
#define PG8_WAIT_V(n) asm volatile("s_waitcnt vmcnt(" #n ")" ::: "memory")
#define PG8_WAIT_L(n) asm volatile("s_waitcnt lgkmcnt(" #n ")" ::: "memory")
#define PG8_BAR __builtin_amdgcn_s_barrier()
#define PG8_SCHED __builtin_amdgcn_sched_barrier(0)
    Unit cur, nxt; int ui = 0;
    if (!S.next(0, cur)) return;
    f32x4 acc[2][2][4][2];
#pragma unroll
    for (int a = 0; a < 2; ++a)
#pragma unroll
        for (int b = 0; b < 2; ++b)
#pragma unroll
            for (int m = 0; m < 4; ++m)
#pragma unroll
                for (int n = 0; n < 2; ++n) acc[a][b][m][n] = (f32x4){0.f, 0.f, 0.f, 0.f};
    bf16x8 At[4][2], B0[2][2], B1[2][2];
    const char* cA = (const char*)g.A + (size_t)cur.pm * tstepA; const char* cB = (const char*)g.Bt + (size_t)cur.pn * tstepB;
    PG8_STAGE(PG8_SB(0, 0), cB, voffB); PG8_STAGE(PG8_SA(0, 0), cA, voffA); PG8_STAGE(PG8_SB(0, 1), cB + hstepB, voffB); PG8_STAGE(PG8_SA(0, 1), cA + hstepA, voffA);
    if (wr == 1) PG8_BAR;
    PG8_WAIT_V(4); PG8_BAR;
    PG8_STAGE(PG8_SB(1, 0), cB + kstep, voffB); PG8_STAGE(PG8_SA(1, 0), cA + kstep, voffA); PG8_STAGE(PG8_SB(1, 1), cB + hstepB + kstep, voffB);
    PG8_WAIT_V(6); PG8_BAR;
    for (;;) {
        const bool has_next = S.next(ui + 1, nxt);
        const char* nA = has_next ? (const char*)g.A + (size_t)nxt.pm * tstepA : cA; const char* nB = has_next ? (const char*)g.Bt + (size_t)nxt.pn * tstepB : cB;
        for (int t = 0; t < nt; t += 2) {
            const bool last = (t == nt - 2);
            const char* a1 = cA + (size_t)(t + 1) * kstep;
            const char* a2 = last ? nA : cA + (size_t)(t + 2) * kstep; const char* b2 = last ? nB : cB + (size_t)(t + 2) * kstep;
            const char* a3 = a2 + kstep; const char* b3 = b2 + kstep;
            PG8_LDB(B0, 0, 0); PG8_SCHED; PG8_LDA(At, 0, 0); PG8_STAGE(PG8_SA(1, 1), a1 + hstepA, voffA);
            PG8_WAIT_L(8); PG8_BAR; PG8_WAIT_L(0); PG8_MMA(0, 0, At, B0); PG8_BAR; PG8_SCHED;
            PG8_LDB(B1, 0, 1); PG8_STAGE(PG8_SB(0, 0), b2, voffB);
            PG8_BAR; PG8_WAIT_L(0); PG8_MMA(0, 1, At, B1); PG8_BAR;
            PG8_LDA(At, 0, 1); PG8_STAGE(PG8_SA(0, 0), a2, voffA);
            PG8_BAR; PG8_WAIT_L(0); PG8_MMA(1, 0, At, B0); PG8_BAR; PG8_SCHED;
            PG8_STAGE(PG8_SB(0, 1), b2 + hstepB, voffB);
            PG8_WAIT_V(6); PG8_BAR; PG8_MMA(1, 1, At, B1); PG8_BAR;
            PG8_LDB(B0, 1, 0); PG8_SCHED; PG8_LDA(At, 1, 0); PG8_STAGE(PG8_SA(0, 1), a2 + hstepA, voffA);
            PG8_WAIT_L(8); PG8_BAR; PG8_WAIT_L(0); PG8_MMA(0, 0, At, B0); PG8_BAR; PG8_SCHED;
            PG8_LDB(B1, 1, 1); PG8_STAGE(PG8_SB(1, 0), b3, voffB);
            PG8_BAR; PG8_WAIT_L(0); PG8_MMA(0, 1, At, B1); PG8_BAR;
            PG8_LDA(At, 1, 1); PG8_STAGE(PG8_SA(1, 0), a3, voffA);
            PG8_BAR; PG8_WAIT_L(0); PG8_MMA(1, 0, At, B0); PG8_BAR; PG8_SCHED;
            PG8_STAGE(PG8_SB(1, 1), b3 + hstepB, voffB);
            PG8_WAIT_V(6); PG8_BAR; PG8_MMA(1, 1, At, B1); PG8_BAR;
        }
        E(acc, cur, wr, wc, fr, fq);
        if (!has_next) break;
#pragma unroll
        for (int a = 0; a < 2; ++a)
#pragma unroll
            for (int b = 0; b < 2; ++b)
#pragma unroll
                for (int m = 0; m < 4; ++m)
#pragma unroll
                    for (int n = 0; n < 2; ++n) acc[a][b][m][n] = (f32x4){0.f, 0.f, 0.f, 0.f};
        cur = nxt; cA = nA; cB = nB; ++ui;
    }
    PG8_WAIT_V(0);
    if (wr == 0) PG8_BAR;
    PG8_BAR;
#undef PG8_SA
#undef PG8_SB
#undef PG8_STAGE
#undef PG8_LDA
#undef PG8_LDB
#undef PG8_MMA
#undef PG8_WAIT_V
#undef PG8_WAIT_L
#undef PG8_BAR
#undef PG8_SCHED
}
}

#define EPI_ROW(u, ai, m) ((u).pm * 256 + (ai) * 128 + wr * 64 + (m) * 16 + fr)
#define EPI_COL(u, bj, n) ((u).pn * 256 + (bj) * 128 + wc * 32 + (n) * 16 + 4 * fq)

struct Epi1 {
    bf16_t* P; const float* rs; int pass; float* pshift; float* sshift; float* carry;
    __device__ __forceinline__ void operator()(const f32x4 (&acc)[2][2][4][2], const pg8::Unit& u, int wr, int wc, int fr, int fq) const {
        float rsv[2][4];
#pragma unroll
        for (int ai = 0; ai < 2; ++ai)
#pragma unroll
            for (int m = 0; m < 4; ++m) rsv[ai][m] = rs[EPI_ROW(u, ai, m)];
#pragma unroll
        for (int ai = 0; ai < 2; ++ai)
#pragma unroll
            for (int m = 0; m < 4; ++m) {
                const int row = EPI_ROW(u, ai, m); const float s = rsv[ai][m];
                float* sdst = nullptr;
                if (pass == 0) { if ((row & 1023) == 1023) sdst = carry + (size_t)(row >> 10) * SHIFTC; }
                else { if (row < 8192) { if ((row & 1023) == 1023) sdst = pshift + (size_t)(row >> 10) * SHIFTC; } else { const int q = row - 8192; if ((q & 3) == 3) sdst = sshift + (size_t)(q >> 2) * SHIFTC; } }
                bf16_t* prow = P + (size_t)row * RWIN;
#pragma unroll
                for (int bj = 0; bj < 2; ++bj)
#pragma unroll
                    for (int n = 0; n < 2; ++n) {
                        const int col = EPI_COL(u, bj, n);
                        if (col < RWIN) {
                            const f32x4 v = acc[ai][bj][m][n] * s;
                            u32x2 o; o.x = pk2(v[0], v[1]); o.y = pk2(v[2], v[3]);
                            *(u32x2*)(prow + col) = o;
                            if (sdst && col < SHIFTC) *(f32x4*)(sdst + col) = v;
                        }
                    }
            }
    }
};
struct Epi2 {
    const float* xp; const float* xs; float* Y; bf16_t* XB; float* ss;
    __device__ __forceinline__ void operator()(const f32x4 (&acc)[2][2][4][2], const pg8::Unit& u, int wr, int wc, int fr, int fq) const {
#pragma unroll
        for (int ai = 0; ai < 2; ++ai) {
            f32x4 xv[4][2][2];
#pragma unroll
            for (int m = 0; m < 4; ++m) { const int row = EPI_ROW(u, ai, m);
                const float* xr = row < MP ? xp + (size_t)row * D : xs + (size_t)(row - MP) * D;
#pragma unroll
                for (int bj = 0; bj < 2; ++bj)
#pragma unroll
                    for (int n = 0; n < 2; ++n) xv[m][bj][n] = *(const f32x4*)(xr + EPI_COL(u, bj, n)); }
#pragma unroll
            for (int m = 0; m < 4; ++m) {
                const int row = EPI_ROW(u, ai, m);
                float part = 0.f;
#pragma unroll
                for (int bj = 0; bj < 2; ++bj)
#pragma unroll
                    for (int n = 0; n < 2; ++n) {
                        const int col = EPI_COL(u, bj, n);
                        const f32x4 v = acc[ai][bj][m][n] + xv[m][bj][n];
                        u32x2 o; o.x = pk2(v[0], v[1]); o.y = pk2(v[2], v[3]);
                        *(u32x2*)(XB + (size_t)row * D + col) = o;
                        part += (v[0] * v[0] + v[1] * v[1]) + (v[2] * v[2] + v[3] * v[3]);
                    }
                part += __shfl_xor(part, 16); part += __shfl_xor(part, 32);
                if (fq == 0 && ss) atomicAdd(ss + row, part);
            }
        }
    }
};
struct Epi3 {
    bf16_t* P; const float* ss1; float* vsum; float* vsq;
    __device__ __forceinline__ void operator()(const f32x4 (&acc)[2][2][4][2], const pg8::Unit& u, int wr, int wc, int fr, int fq) const {
        const int region = u.pn >> 3;
        float sv8[2][4];
#pragma unroll
        for (int ai = 0; ai < 2; ++ai)
#pragma unroll
            for (int m = 0; m < 4; ++m) sv8[ai][m] = ss1[EPI_ROW(u, ai, m)];
#pragma unroll
        for (int ai = 0; ai < 2; ++ai)
#pragma unroll
            for (int m = 0; m < 4; ++m) {
                const int row = EPI_ROW(u, ai, m);
                const float s = rsqrtf(sv8[ai][m] * (1.f / D) + 1e-6f);
                float p1 = 0.f, p2 = 0.f;
#pragma unroll
                for (int bj = 0; bj < 2; ++bj)
#pragma unroll
                    for (int n = 0; n < 2; ++n) {
                        const int col = EPI_COL(u, bj, n);
                        f32x4 v = acc[ai][bj][m][n] * s;
                        if (region == 2) { v[0] = v[0] * sigmoidf_(v[0]); v[1] = v[1] * sigmoidf_(v[1]); v[2] = v[2] * sigmoidf_(v[2]); v[3] = v[3] * sigmoidf_(v[3]); }
                        else { v[0] = gelu_tanh(v[0]); v[1] = gelu_tanh(v[1]); v[2] = gelu_tanh(v[2]); v[3] = gelu_tanh(v[3]); }
                        if (region == 1) { p1 += (v[0] + v[1]) + (v[2] + v[3]); p2 += (v[0] * v[0] + v[1] * v[1]) + (v[2] * v[2] + v[3] * v[3]); }
                        u32x2 o; o.x = pk2(v[0], v[1]); o.y = pk2(v[2], v[3]);
                        *(u32x2*)(P + (size_t)row * GMIN + col) = o;
                    }
                if (region == 1) {
                    p1 += __shfl_xor(p1, 16); p1 += __shfl_xor(p1, 32); p2 += __shfl_xor(p2, 16); p2 += __shfl_xor(p2, 32);
                    if (fq == 0) { atomicAdd(vsum + row, p1); atomicAdd(vsq + row, p2); }
                }
            }
    }
};
struct Epi4 {
    float* Y; float* ss; const bf16_t* XB;
    __device__ __forceinline__ void operator()(const f32x4 (&acc)[2][2][4][2], const pg8::Unit& u, int wr, int wc, int fr, int fq) const {
#pragma unroll
        for (int ai = 0; ai < 2; ++ai) {
            u32x2 xv[4][2][2];
#pragma unroll
            for (int m = 0; m < 4; ++m)
#pragma unroll
                for (int bj = 0; bj < 2; ++bj)
#pragma unroll
                    for (int n = 0; n < 2; ++n) xv[m][bj][n] = *(const u32x2*)(XB + (size_t)EPI_ROW(u, ai, m) * D + EPI_COL(u, bj, n));
#pragma unroll
            for (int m = 0; m < 4; ++m) {
                const int row = EPI_ROW(u, ai, m);
                float part = 0.f;
#pragma unroll
                for (int bj = 0; bj < 2; ++bj)
#pragma unroll
                    for (int n = 0; n < 2; ++n) {
                        const u32x2 q = xv[m][bj][n];
                        const f32x4 v = acc[ai][bj][m][n] + (f32x4){bflo(q.x), bfhi(q.x), bflo(q.y), bfhi(q.y)};
                        *(f32x4*)(Y + (size_t)row * D + EPI_COL(u, bj, n)) = v;
                        part += (v[0] * v[0] + v[1] * v[1]) + (v[2] * v[2] + v[3] * v[3]);
                    }
                part += __shfl_xor(part, 16); part += __shfl_xor(part, 32);
                if (fq == 0) atomicAdd(ss + row, part);
            }
        }
    }
};
struct EpiNull { float* sink; int never;
    __device__ __forceinline__ void operator()(const f32x4 (&acc)[2][2][4][2], const pg8::Unit& u, int wr, int wc, int fr, int fq) const {
        if (never) {
#pragma unroll
            for (int ai = 0; ai < 2; ++ai)
#pragma unroll
                for (int m = 0; m < 4; ++m)
#pragma unroll
                    for (int bj = 0; bj < 2; ++bj)
#pragma unroll
                        for (int n = 0; n < 2; ++n) *(f32x4*)(sink + (size_t)EPI_ROW(u, ai, m) * D + EPI_COL(u, bj, n)) = acc[ai][bj][m][n];
        }
    }
};

#define XB_TMO      128
#define XB_XCNT(j)  (256  + 64 * (j))
#define XB_XSUB(j)  (1280 + 64 * (j))
#define XB_XGEN(j)  (2304 + 64 * (j))
#define XB_TOP      3328
#define XB_TOPGEN   3392
#define XCD_BAR_WORDS 3456
#define XB_SPIN_CAP (1u << 18)
__device__ __forceinline__ unsigned xb_ld(unsigned* p)              { return __hip_atomic_load(p, __ATOMIC_RELAXED, __HIP_MEMORY_SCOPE_AGENT); }
__device__ __forceinline__ unsigned xb_add(unsigned* p, unsigned v) { return __hip_atomic_fetch_add(p, v, __ATOMIC_RELAXED, __HIP_MEMORY_SCOPE_AGENT); }
__device__ __forceinline__ unsigned xb_xcc_id() { return (unsigned)__builtin_amdgcn_s_getreg((3 << 11) | 20) & 0xFu; }
#define XB_SPIN(cond, bar) do { unsigned _sp = 0; while (cond) { __builtin_amdgcn_s_sleep(1); \
    if ((++_sp & 255u) == 0u) { if (xb_ld(&(bar)[XB_TMO])) break; if (_sp > XB_SPIN_CAP) { atomicAdd(&(bar)[XB_TMO], 1u); break; } } } } while (0)
struct XcdBarrier { unsigned* bar; unsigned x; volatile LAS unsigned* st; };
__device__ __forceinline__ XcdBarrier xcd_barrier_post(unsigned* bar, volatile LAS unsigned* st) {
    XcdBarrier b; b.bar = bar; b.x = xb_xcc_id(); b.st = st;
    if (threadIdx.x == 0) (void)xb_add(&bar[XB_XCNT(b.x)], 1u);
    return b;
}
__device__ __forceinline__ void xcd_barrier_complete(unsigned* bar, unsigned x, unsigned& nloc, unsigned& nx) {
    const unsigned G = gridDim.x * gridDim.y * gridDim.z;
    unsigned sum, cnt, mine, sp = 0u;
    for (;;) {
        sum = 0u; cnt = 0u; mine = 0u;
#pragma unroll
        for (unsigned j = 0; j < 16; ++j) { const unsigned c = xb_ld(&bar[XB_XCNT(j)]); sum += c; cnt += (c > 0u) ? 1u : 0u; mine = (j == x) ? c : mine; }
        if (sum == G) break;
        __builtin_amdgcn_s_sleep(1);
        if ((++sp & 255u) == 0u) { if (xb_ld(&bar[XB_TMO])) break; if (sp > XB_SPIN_CAP) { atomicAdd(&bar[XB_TMO], 1u); break; } }
    }
    nloc = mine > 0u ? mine : 1u; nx = cnt > 0u ? cnt : 1u;
}
__device__ __forceinline__ void xcd_barrier(const XcdBarrier& b) {
    asm volatile("s_waitcnt vmcnt(0)" ::: "memory");
    __syncthreads();
    if (threadIdx.x == 0) {
        unsigned* bar = b.bar;
        __builtin_amdgcn_s_waitcnt(0);
        unsigned nloc = b.st[0], nx = b.st[1];
        if (nloc == 0u) { xcd_barrier_complete(bar, b.x, nloc, nx); b.st[0] = nloc; b.st[1] = nx; }
        const unsigned old = xb_add(&bar[XB_XSUB(b.x)], 1u);
        const unsigned gen = old / nloc;
        if (old + 1u == (gen + 1u) * nloc) {
            __builtin_amdgcn_fence(__ATOMIC_RELEASE, "agent");
            asm volatile("s_waitcnt vmcnt(0)" ::: "memory");
            const unsigned og = xb_add(&bar[XB_TOP], 1u);
            const unsigned tg = og / nx;
            if (og + 1u == (tg + 1u) * nx) xb_add(&bar[XB_TOPGEN], 1u);
            else XB_SPIN(xb_ld(&bar[XB_TOPGEN]) == tg, bar);
            __builtin_amdgcn_fence(__ATOMIC_ACQUIRE, "agent");
            xb_add(&bar[XB_XGEN(b.x)], 1u);
            asm volatile("s_waitcnt vmcnt(0)" ::: "memory");
        } else {
            XB_SPIN(xb_ld(&bar[XB_XGEN(b.x)]) == gen, bar);
            __builtin_amdgcn_fence(__ATOMIC_ACQUIRE, "agent");
            asm volatile("s_waitcnt vmcnt(0)" ::: "memory");
        }
    }
    __syncthreads();
}

struct Frame {
    unsigned char* lds; int tid, lane, wave, G, bid;
    const float* const* in; float* out; unsigned char* ws; float* misc;
};

__device__ __forceinline__ void p0_transpose_item(const float* W, int K, int N, bf16_t* WT, const float* g, float* scr, int item, int lane) {
    const int nblk = N / 32, kb = item / nblk, nb = item % nblk, k0 = 64 * kb, n0 = 32 * nb;
#pragma unroll
    for (int i = 0; i < 32; ++i) { const int kk = 2 * i + (lane >> 5); float v = W[(size_t)(k0 + kk) * N + n0 + (lane & 31)]; if (g) v *= g[k0 + kk]; scr[kk * 33 + (lane & 31)] = v; }
    LDS_WAIT();
    const int c = lane & 7;
#pragma unroll
    for (int j = 0; j < 4; ++j) { const int n = (lane >> 3) + 8 * j; const float* s = scr + (8 * c) * 33 + n;
        u32x4 o; o.x = pk2(s[0 * 33], s[1 * 33]); o.y = pk2(s[2 * 33], s[3 * 33]); o.z = pk2(s[4 * 33], s[5 * 33]); o.w = pk2(s[6 * 33], s[7 * 33]);
        *(u32x4*)(WT + (size_t)(n0 + n) * K + k0 + 8 * c) = o; }
    LDS_WAIT();
}
__device__ __forceinline__ void phase_prologue(Frame& F) {
    float* scr = (float*)(F.lds + F.wave * 16384);
    const int gw = F.bid * NWAVES + F.wave, NGW = F.G * NWAVES;
    bf16_t* W1T = (bf16_t*)(F.ws + WS_W1T); bf16_t* W2T = (bf16_t*)(F.ws + WS_W2T); bf16_t* W3T = (bf16_t*)(F.ws + WS_W3T); bf16_t* W4T = (bf16_t*)(F.ws + WS_W4T);
    constexpr int I1 = (D / 64) * (RWIN / 32), I2 = (E / 64) * (D / 32), I3 = (D / 64) * (GMIN / 32), I4 = (E / 64) * (D / 32);
    for (int it = gw; it < I1 + I2 + I3 + I4; it += NGW) {
        int r = it;
        if (r < I1) { p0_transpose_item(F.in[6], D, RWIN, W1T, F.in[4], scr, r, F.lane); continue; } r -= I1;
        if (r < I2) { p0_transpose_item(F.in[17], E, D, W2T, nullptr, scr, r, F.lane); continue; } r -= I2;
        if (r < I3) { p0_transpose_item(F.in[18], D, GMIN, W3T, F.in[4] + D, scr, r, F.lane); continue; } r -= I3;
        p0_transpose_item(F.in[23], E, D, W4T, nullptr, scr, r, F.lane);
    }
    { u32x4* z = (u32x4*)(W1T + (size_t)RWIN * D); const int n = (RWIN_PAD - RWIN) * D * 2 / 16;
      for (int i = F.bid * NTHREADS + F.tid; i < n; i += F.G * NTHREADS) z[i] = (u32x4){0u, 0u, 0u, 0u};
      float* zs = F.misc + MI_SS1; for (int i = F.bid * NTHREADS + F.tid; i < 4 * MTOT; i += F.G * NTHREADS) zs[i] = 0.f; }
    bf16_t* XB = (bf16_t*)(F.out + OFF_SWKV);
    for (int gr = gw; gr < MTOT; gr += NGW) {
        const float* xr = gr < MP ? F.in[0] + (size_t)gr * D : F.in[1] + (size_t)(gr - MP) * D;
        int pmi;
        if (gr < MP) { const int b = gr >> 11, t = gr & 2047; pmi = t < 1024 ? b * 1024 + t : PA_ROWS + b * 1024 + (t - 1024); } else pmi = gr;
        const f32x4* x4 = (const f32x4*)xr + F.lane;
        f32x4 v[4]; float s = 0.f;
#pragma unroll
        for (int j = 0; j < 4; ++j) { v[j] = x4[64 * j]; s += (v[j][0] * v[j][0] + v[j][1] * v[j][1]) + (v[j][2] * v[j][2] + v[j][3] * v[j][3]); }
        s = wave_sum(s);
        u32x2* o = (u32x2*)(XB + (size_t)pmi * D) + F.lane;
#pragma unroll
        for (int j = 0; j < 4; ++j) { u32x2 w; w.x = pk2(v[j][0], v[j][1]); w.y = pk2(v[j][2], v[j][3]); o[64 * j] = w; }
        if (F.lane == 0) F.misc[MI_RS0 + pmi] = rsqrtf(s * (1.f / D) + 1e-6f);
    }
}

constexpr int TT = 32;
#define WKV_STEP(S, pW, pA, pB, pK, pR, vval, yout) do { \
    float sa0 = 0.f, sa1 = 0.f; \
    _Pragma("unroll") for (int k4 = 0; k4 < 16; ++k4) { const f32x4 a = ((const f32x4*)(pA))[k4]; sa0 += S[4 * k4] * a[0] + S[4 * k4 + 2] * a[2]; sa1 += S[4 * k4 + 1] * a[1] + S[4 * k4 + 3] * a[3]; } \
    const float sa = sa0 + sa1; float y0 = 0.f, y1 = 0.f; \
    _Pragma("unroll") for (int k4 = 0; k4 < 16; ++k4) { const f32x4 w = ((const f32x4*)(pW))[k4], bb = ((const f32x4*)(pB))[k4], kk = ((const f32x4*)(pK))[k4], rr = ((const f32x4*)(pR))[k4]; \
        _Pragma("unroll") for (int e = 0; e < 4; ++e) { float s = S[4 * k4 + e] * w[e] + sa * bb[e] + (vval) * kk[e]; S[4 * k4 + e] = s; if (e & 1) y1 += s * rr[e]; else y0 += s * rr[e]; } } \
    (yout) = y0 + y1; } while (0)

__device__ __forceinline__ void load_tok(const bf16_t* P, const float* carry, int pass, int b, int hc, int c, int t, unsigned (&x)[6]) {
    const bf16_t* pr = P + (size_t)(b * 1024 + t) * RWIN;
    unsigned s0 = pr[hc + c], s1 = pr[E + hc + c], s2 = pr[2 * E + hc + c], s3 = pr[3 * E + c], s4 = pr[3 * E + 64 + c];
    x[5] = pr[SHIFTC + hc + c];
    unsigned q0 = 0, q1 = 0, q2 = 0, q3 = 0, q4 = 0;
    if (t > 0) { const bf16_t* pp = pr - RWIN; q0 = pp[hc + c]; q1 = pp[E + hc + c]; q2 = pp[2 * E + hc + c]; q3 = pp[3 * E + c]; q4 = pp[3 * E + 64 + c]; }
    else if (pass != 0) { const float* cr = carry + (size_t)b * SHIFTC;
        q0 = pk2(cr[hc + c], 0.f) & 0xffffu; q1 = pk2(cr[E + hc + c], 0.f) & 0xffffu; q2 = pk2(cr[2 * E + hc + c], 0.f) & 0xffffu; q3 = pk2(cr[3 * E + c], 0.f) & 0xffffu; q4 = pk2(cr[3 * E + 64 + c], 0.f) & 0xffffu; }
    x[0] = s0 | (q0 << 16); x[1] = s1 | (q1 << 16); x[2] = s2 | (q2 << 16); x[3] = s3 | (q3 << 16); x[4] = s4 | (q4 << 16);
}
__device__ __forceinline__ void scan_prompt(Frame& F, int pass) {
    unsigned char* Lb = F.lds;
    bf16_t* W2Tb = (bf16_t*)Lb; bf16_t* A2Tb = (bf16_t*)(Lb + 9216);
    float* PAR = (float*)(Lb + 18432);
    bf16_t* SHI = (bf16_t*)(Lb + 22528); bf16_t* SLO = (bf16_t*)(Lb + 31744);
    bf16_t* TWb = (bf16_t*)(Lb + 40960); bf16_t* TAb = (bf16_t*)(Lb + 45568);
    bf16_t* AHb = TWb; bf16_t* RHb = TAb;
    float* VW = (float*)(Lb + 50176); float* VA = VW + 2048; float* VB = VA + 2048; float* VK = VB + 2048; float* VR = VK + 2048; float* VV = VR + 2048; float* VY = VV + 2048;
    float* UT = VW; float* YT = VB;
    bf16_t* ATb = (bf16_t*)(Lb + 107520); bf16_t* BTb = ATb + 2304; bf16_t* KTb = BTb + 2304; bf16_t* RTb = KTb + 2304;
    bf16_t* BKpT = (bf16_t*)(Lb + 125952);
    bf16_t* UVT = (bf16_t*)(Lb + 136192);
    float* GR = (float*)(Lb + 146432);
    float* PC = (float*)(Lb + 154624);
    float* BON = (float*)(Lb + 155136);
    bf16_t* GLb = (bf16_t*)(Lb + 155264);
    const bf16_t* P = (const bf16_t*)(F.ws + WS_PROJH);
    bf16_t* O = (bf16_t*)(F.ws + WS_O);
    const float* carry = F.misc + MI_CARRY;
    float* pwkv = F.out + OFF_PWKV;
    const int lane = F.lane, tid = F.tid, wave = F.wave, fr = lane & 15, fq = lane >> 4;
    for (int u = F.bid; u < 256; u += F.G) {
        const int b = u >> 5, h = u & 31, hc = h * 64;
        __syncthreads();
        for (int idx = tid; idx < 4096; idx += NTHREADS) { const int j = idx >> 6, c = idx & 63;
            W2Tb[c * 72 + j] = (bf16_t)(pk2(F.in[9][(size_t)j * E + hc + c], 0.f) & 0xffffu); A2Tb[c * 72 + j] = (bf16_t)(pk2(F.in[11][(size_t)j * E + hc + c], 0.f) & 0xffffu); }
        for (int idx = tid; idx < 2 * 64 * 8; idx += NTHREADS) { const int r = idx >> 3, q = idx & 7; *(unsigned*)(UVT + r * 40 + 2 * q) = 0u; }
        if (tid < 64) { const int c = tid;
            PAR[0 * 64 + c] = F.in[7][hc + c]; PAR[1 * 64 + c] = F.in[7][E + hc + c]; PAR[2 * 64 + c] = F.in[7][2 * E + hc + c]; PAR[3 * 64 + c] = F.in[7][3 * E + c]; PAR[4 * 64 + c] = F.in[7][3 * E + 64 + c];
            PAR[5 * 64 + c] = F.in[8][hc + c]; PAR[6 * 64 + c] = F.in[10][hc + c]; PAR[7 * 64 + c] = F.in[12][hc + c]; PAR[8 * 64 + c] = F.in[13][hc + c]; PAR[9 * 64 + c] = F.in[14][hc + c];
            PAR[10 * 64 + c] = F.in[15][hc + c]; PAR[11 * 64 + c] = F.in[16][hc + c]; }
        const int vt = wave & 3, kt0 = 2 * (wave >> 2);
        f32x4 accS[2];
        float* sgp = pwkv + ((size_t)(b * NH + h) * 64 + 16 * vt + fr) * 64 + 16 * kt0 + 4 * fq;
        if (pass == 0) { accS[0] = (f32x4){0.f, 0.f, 0.f, 0.f}; accS[1] = accS[0]; }
        else { accS[0] = *(const f32x4*)sgp; accS[1] = *(const f32x4*)(sgp + 16); }
#pragma unroll
        for (int q = 0; q < 2; ++q) {
            const unsigned h01 = pk2(accS[q][0], accS[q][1]), h23 = pk2(accS[q][2], accS[q][3]);
            const unsigned l01 = pk2(accS[q][0] - bflo(h01), accS[q][1] - bfhi(h01)), l23 = pk2(accS[q][2] - bflo(h23), accS[q][3] - bfhi(h23));
            u32x2 hv; hv.x = h01; hv.y = h23; u32x2 lv; lv.x = l01; lv.y = l23;
            *(u32x2*)(SHI + (16 * vt + fr) * 72 + 16 * (kt0 + q) + 4 * fq) = hv; *(u32x2*)(SLO + (16 * vt + fr) * 72 + 16 * (kt0 + q) + 4 * fq) = lv;
        }
        unsigned X[4][6];
#pragma unroll
        for (int i = 0; i < 4; ++i) load_tok(P, carry, pass, b, hc, lane, wave + NWAVES * i, X[i]);
        __syncthreads();
#pragma unroll 1
        for (int c0 = 0; c0 < 1024; c0 += TT) {
            float zc[4];
#pragma unroll
            for (int i = 0; i < 4; ++i) {
                const int tl = wave + NWAVES * i, c = lane;
                const float rv = bflo(X[i][0]) + (bfhi(X[i][0]) - bflo(X[i][0])) * PAR[c], kv = bflo(X[i][1]) + (bfhi(X[i][1]) - bflo(X[i][1])) * PAR[64 + c], vv = bflo(X[i][2]) + (bfhi(X[i][2]) - bflo(X[i][2])) * PAR[128 + c];
                const float wd = bflo(X[i][3]) + (bfhi(X[i][3]) - bflo(X[i][3])) * PAR[192 + c], ad = bflo(X[i][4]) + (bfhi(X[i][4]) - bflo(X[i][4])) * PAR[256 + c];
                zc[i] = bflo(X[i][5]);
                VR[tl * 64 + c] = rv; VK[tl * 64 + c] = kv; VV[tl * 64 + c] = vv;
                UVT[(tl >> 4) * 2560 + c * 40 + 16 + (tl & 15)] = (bf16_t)(pk2(vv, 0.f) & 0xffffu);
                TWb[tl * 72 + c] = (bf16_t)(pk2(tanh_(wd), 0.f) & 0xffffu); TAb[tl * 72 + c] = (bf16_t)(pk2(ad, 0.f) & 0xffffu);
                float kk = kv * PAR[7 * 64 + c];
                const float nrm = wave_sum(kk * kk);
                VA[tl * 64 + c] = -(kk * rsqrtf(fmaxf(nrm, 1e-24f)));
            }
            LBAR();
            if (c0 + TT < 1024) {
#pragma unroll
                for (int i = 0; i < 4; ++i) load_tok(P, carry, pass, b, hc, lane, c0 + TT + wave + NWAVES * i, X[i]);
            }
            { const int tt = wave & 1, ct = wave >> 1;
              f32x4 aw = (f32x4){0.f, 0.f, 0.f, 0.f}, aa = (f32x4){0.f, 0.f, 0.f, 0.f};
#pragma unroll
              for (int k2 = 0; k2 < 2; ++k2) {
                  const bf16x8 xw = *(const bf16x8*)(W2Tb + (ct * 16 + fr) * 72 + k2 * 32 + fq * 8), yw = *(const bf16x8*)(TWb + (tt * 16 + fr) * 72 + k2 * 32 + fq * 8);
                  const bf16x8 xa = *(const bf16x8*)(A2Tb + (ct * 16 + fr) * 72 + k2 * 32 + fq * 8), ya = *(const bf16x8*)(TAb + (tt * 16 + fr) * 72 + k2 * 32 + fq * 8);
                  aw = __builtin_amdgcn_mfma_f32_16x16x32_bf16(xw, yw, aw, 0, 0, 0); aa = __builtin_amdgcn_mfma_f32_16x16x32_bf16(xa, ya, aa, 0, 0, 0);
              }
              const int tl = tt * 16 + fr, c4 = ct * 16 + 4 * fq;
              *(f32x4*)(VW + tl * 64 + c4) = aw; *(f32x4*)(VB + tl * 64 + c4) = aa; }
            LBAR();
#pragma unroll
            for (int i = 0; i < 4; ++i) {
                const int tl = wave + NWAVES * i, c = lane;
                const float wf = PAR[5 * 64 + c] + VW[tl * 64 + c], af = PAR[6 * 64 + c] + VB[tl * 64 + c];
                const float dec = __expf(-0.6065306597126334f * sigmoidf_(wf));
                const float av = sigmoidf_(af);
                const float kraw = VK[tl * 64 + c], rv = VR[tl * 64 + c], kkn = -VA[tl * 64 + c];
                const float kp = kraw * (1.f + (av - 1.f) * PAR[8 * 64 + c]);
                const float bon = wave_sum(rv * kp * PAR[9 * 64 + c]);
                VW[tl * 64 + c] = dec; VB[tl * 64 + c] = kkn * av; VK[tl * 64 + c] = kp;
                if (c == 0) BON[tl] = bon;
            }
            LBAR();
            if (wave < 2) {
                const int ch = wave, r0 = ch * 16, k = lane;
                float p = 1.f;
#pragma unroll 4
                for (int i = 0; i < 16; ++i) {
                    const int o = (r0 + i) * 64 + k;
                    const float w = VW[o], av = VA[o], bv = VB[o], kv = VK[o], rv = VR[o];
                    const float at = av * p; p *= w; const float ip = rcp_(p);
                    const float bt = bv * ip, kt = kv * ip, rt = rv * p;
                    ATb[ch * 1152 + i * 72 + k] = (bf16_t)(pk2(at, 0.f) & 0xffffu); BTb[ch * 1152 + i * 72 + k] = (bf16_t)(pk2(bt, 0.f) & 0xffffu);
                    KTb[ch * 1152 + i * 72 + k] = (bf16_t)(pk2(kt, 0.f) & 0xffffu); RTb[ch * 1152 + i * 72 + k] = (bf16_t)(pk2(rt, 0.f) & 0xffffu);
                    VA[o] = at; VR[o] = rt; VB[o] = bt; VK[o] = kt;
                }
                PC[ch * 64 + k] = p;
#pragma unroll 4
                for (int i = 0; i < 16; i += 2) {
                    const int o = (r0 + i) * 64 + k;
                    *(unsigned*)(BKpT + ch * 2560 + k * 40 + i) = pk2(VB[o] * p, VB[o + 64] * p);
                    *(unsigned*)(BKpT + ch * 2560 + k * 40 + 16 + i) = pk2(VK[o] * p, VK[o + 64] * p);
                }
            }
            LBAR();
            { const int ch = wave >> 2, which = wave & 3;
              const bf16_t* Xp = ((which < 2) ? ATb : RTb) + ch * 1152; const bf16_t* Yp = ((which & 1) ? KTb : BTb) + ch * 1152;
              f32x4 g = (f32x4){0.f, 0.f, 0.f, 0.f};
#pragma unroll
              for (int k2 = 0; k2 < 2; ++k2) { const bf16x8 xf = *(const bf16x8*)(Xp + fr * 72 + k2 * 32 + fq * 8), yf = *(const bf16x8*)(Yp + fr * 72 + k2 * 32 + fq * 8);
                  g = __builtin_amdgcn_mfma_f32_16x16x32_bf16(xf, yf, g, 0, 0, 0); }
              float* gp = GR + (ch * 4 + which) * 256;
#pragma unroll
              for (int jj = 0; jj < 4; ++jj) { const int i = 4 * fq + jj, j = fr; const bool keep = (which < 2) ? (j < i) : (j <= i); const float gv = keep ? g[jj] : 0.f; gp[i * 16 + j] = gv;
                  if (which & 1) { bf16_t* gl = GLb + (ch * 2 + (which >> 1)) * 640 + i * 40; gl[j] = 0; gl[16 + j] = (bf16_t)(pk2(gv, 0.f) & 0xffffu); } } }
            LBAR();
            { const int ch = wave >> 2, vt2 = wave & 3;
              const bf16x8 yf = *(const bf16x8*)(UVT + ch * 2560 + (16 * vt2 + fr) * 40 + fq * 8);
              const bf16x8 x1 = *(const bf16x8*)(GLb + (ch * 2 + 0) * 640 + fr * 40 + fq * 8), x2 = *(const bf16x8*)(GLb + (ch * 2 + 1) * 640 + fr * 40 + fq * 8);
              const f32x4 z4 = (f32x4){0.f, 0.f, 0.f, 0.f};
              const f32x4 t1 = __builtin_amdgcn_mfma_f32_16x16x32_bf16(x1, yf, z4, 0, 0, 0), t2 = __builtin_amdgcn_mfma_f32_16x16x32_bf16(x2, yf, z4, 0, 0, 0);
              *(f32x4*)(UT + ch * 1024 + (16 * vt2 + fr) * 16 + 4 * fq) = t1; *(f32x4*)(YT + ch * 1024 + (16 * vt2 + fr) * 16 + 4 * fq) = t2; }
            LBAR();
            if (wave < 4) {
                const int ch = wave >> 1, r0 = ch * 16, col = lane;
                const f32x4* Lab4 = (const f32x4*)(GR + (ch * 4 + 0) * 256); const f32x4* Mrb4 = (const f32x4*)(GR + (ch * 4 + 2) * 256);
                float x[16];
                const bool kcol = (wave & 1) == 0;
                float* ut = UT + ch * 1024 + col * 16; float* yt = YT + ch * 1024 + col * 16;
#pragma unroll
                for (int i = 0; i < 16; ++i) { float a0 = kcol ? VA[(r0 + i) * 64 + col] : ut[i], a1 = 0.f;
#pragma unroll
                    for (int j4 = 0; j4 < (i + 3) / 4; ++j4) { const f32x4 g = Lab4[i * 4 + j4];
#pragma unroll
                        for (int e = 0; e < 4; ++e) { const int j = 4 * j4 + e; if (j < i) { if (j & 1) a1 += g[e] * x[j]; else a0 += g[e] * x[j]; } } }
                    x[i] = a0 + a1;
                    if (kcol) AHb[ch * 1152 + i * 72 + col] = (bf16_t)(pk2(x[i], 0.f) & 0xffffu); else ut[i] = x[i];
                    asm volatile("" ::: "memory"); }
#pragma unroll
                for (int i = 0; i < 16; ++i) { float a0 = kcol ? VR[(r0 + i) * 64 + col] : yt[i], a1 = 0.f;
#pragma unroll
                    for (int j4 = 0; j4 < i / 4 + 1; ++j4) { const f32x4 g = Mrb4[i * 4 + j4];
#pragma unroll
                        for (int e = 0; e < 4; ++e) { const int j = 4 * j4 + e; if (j <= i) { if (j & 1) a1 += g[e] * x[j]; else a0 += g[e] * x[j]; } } }
                    if (kcol) RHb[ch * 1152 + i * 72 + col] = (bf16_t)(pk2(a0 + a1, 0.f) & 0xffffu); else yt[i] = a0 + a1;
                    asm volatile("" ::: "memory"); }
            }
            LBAR();
#pragma unroll 1
            for (int ch = 0; ch < 2; ++ch) {
                { const int vt2 = wave & 3; const bf16_t* Xp = ((wave < 4) ? AHb : RHb) + ch * 1152;
                  f32x4 d = (f32x4){0.f, 0.f, 0.f, 0.f};
#pragma unroll
                  for (int k2 = 0; k2 < 2; ++k2) { const bf16x8 xf = *(const bf16x8*)(Xp + fr * 72 + k2 * 32 + fq * 8);
                      const bf16x8 yh = *(const bf16x8*)(SHI + (16 * vt2 + fr) * 72 + k2 * 32 + fq * 8), yl = *(const bf16x8*)(SLO + (16 * vt2 + fr) * 72 + k2 * 32 + fq * 8);
                      d = __builtin_amdgcn_mfma_f32_16x16x32_bf16(xf, yh, d, 0, 0, 0); d = __builtin_amdgcn_mfma_f32_16x16x32_bf16(xf, yl, d, 0, 0, 0); }
                  if (wave < 4) { const f32x4 uu = d + *(const f32x4*)(UT + ch * 1024 + (16 * vt2 + fr) * 16 + 4 * fq);
                      u32x2 o; o.x = pk2(uu[0], uu[1]); o.y = pk2(uu[2], uu[3]); *(u32x2*)(UVT + ch * 2560 + (16 * vt2 + fr) * 40 + 4 * fq) = o; }
                  else { const f32x4 yy = d + *(const f32x4*)(YT + ch * 1024 + (16 * vt2 + fr) * 16 + 4 * fq);
#pragma unroll
                      for (int jj = 0; jj < 4; ++jj) VY[(ch * 16 + 4 * fq + jj) * 64 + 16 * vt2 + fr] = yy[jj]; } }
                LBAR();
#pragma unroll
                for (int q = 0; q < 2; ++q) { const int kt = kt0 + q;
                    const f32x4 pc = *(const f32x4*)(PC + ch * 64 + 16 * kt + 4 * fq);
                    const bf16x8 xf = *(const bf16x8*)(BKpT + ch * 2560 + (16 * kt + fr) * 40 + fq * 8), yf = *(const bf16x8*)(UVT + ch * 2560 + (16 * vt + fr) * 40 + fq * 8);
                    accS[q] = __builtin_amdgcn_mfma_f32_16x16x32_bf16(xf, yf, accS[q] * pc, 0, 0, 0);
                    const unsigned h01 = pk2(accS[q][0], accS[q][1]), h23 = pk2(accS[q][2], accS[q][3]);
                    const unsigned l01 = pk2(accS[q][0] - bflo(h01), accS[q][1] - bfhi(h01)), l23 = pk2(accS[q][2] - bflo(h23), accS[q][3] - bfhi(h23));
                    u32x2 hv; hv.x = h01; hv.y = h23; u32x2 lv; lv.x = l01; lv.y = l23;
                    *(u32x2*)(SHI + (16 * vt + fr) * 72 + 16 * kt + 4 * fq) = hv; *(u32x2*)(SLO + (16 * vt + fr) * 72 + 16 * kt + 4 * fq) = lv; }
                LBAR();
            }
#pragma unroll
            for (int i = 0; i < 4; ++i) {
                const int tl = wave + NWAVES * i, c = lane;
                const float y = VY[tl * 64 + c];
                const float mean = wave_sum(y) * (1.f / 64.f); const float dy = y - mean;
                const float var = wave_sum(dy * dy) * (1.f / 64.f);
                const float yn = dy * rsqrtf(var + 64e-5f) * PAR[10 * 64 + c] + PAR[11 * 64 + c];
                const float z = zc[i];
                const float o = (yn + BON[tl] * VV[tl * 64 + c]) * (z * sigmoidf_(z));
                const int grow = b * 2048 + pass * 1024 + c0 + tl;
                const float o2 = __shfl_down(o, 1);
                if (!(c & 1)) *(unsigned*)(O + (size_t)grow * E + hc + c) = pk2(o, o2);
            }
            LBAR();
        }
        { *(f32x4*)sgp = accS[0]; *(f32x4*)(sgp + 16) = accS[1]; }
    }
    __syncthreads();
}

__device__ __forceinline__ void scan_samples(Frame& F) {
    float* scr = (float*)F.lds + F.wave * 2560;
    float* TW = scr; float* TA = scr + 256; float* VW = scr + 512; float* VA = scr + 768; float* VB = scr + 1024; float* VK = scr + 1280; float* VR = scr + 1536; float* VV = scr + 1792; float* VY = scr + 2048; float* BON = scr + 2304;
    const bf16_t* P = (const bf16_t*)(F.ws + WS_PROJH);
    bf16_t* O = (bf16_t*)(F.ws + WS_O);
    const int c = F.lane;
    const int gw = F.bid * NWAVES + F.wave, NGW = F.G * NWAVES;
    for (int su = gw; su < 128 * NH; su += NGW) {
        const int sb = su >> 5, h = su & 31, hc = h * 64;
        const float mur = F.in[7][hc + c], muk = F.in[7][E + hc + c], muv = F.in[7][2 * E + hc + c], muwd = F.in[7][3 * E + c], muad = F.in[7][3 * E + 64 + c];
        const float* st = F.in[2] + (size_t)sb * SHIFTC;
        float qr = st[hc + c], qk = st[E + hc + c], qv = st[2 * E + hc + c], qwd = st[3 * E + c], qad = st[3 * E + 64 + c];
        float r[4], k[4], v[4];
        LDS_WAIT();
#pragma unroll
        for (int tl = 0; tl < 4; ++tl) {
            const bf16_t* pr = P + (size_t)(PA_ROWS + sb * 4 + tl) * RWIN;
            const float sr = bf2f(pr[hc + c]), sk = bf2f(pr[E + hc + c]), sv = bf2f(pr[2 * E + hc + c]), swd = bf2f(pr[3 * E + c]), sad = bf2f(pr[3 * E + 64 + c]);
            r[tl] = sr + (qr - sr) * mur; k[tl] = sk + (qk - sk) * muk; v[tl] = sv + (qv - sv) * muv;
            TW[tl * 64 + c] = tanhf(swd + (qwd - swd) * muwd); TA[tl * 64 + c] = sad + (qad - sad) * muad;
            qr = sr; qk = sk; qv = sv; qwd = swd; qad = sad;
        }
        LDS_WAIT();
        float wf[4], af[4];
        { const float w0 = F.in[8][hc + c], a0 = F.in[10][hc + c];
#pragma unroll
          for (int tl = 0; tl < 4; ++tl) { wf[tl] = w0; af[tl] = a0; } }
#pragma unroll 16
        for (int j = 0; j < 64; ++j) {
            const float w2 = F.in[9][(size_t)j * E + hc + c], a2 = F.in[11][(size_t)j * E + hc + c];
#pragma unroll
            for (int tl = 0; tl < 4; ++tl) { wf[tl] += TW[tl * 64 + j] * w2; af[tl] += TA[tl * 64 + j] * a2; }
        }
        const float kkp = F.in[12][hc + c], kap = F.in[13][hc + c], rkp = F.in[14][hc + c];
#pragma unroll
        for (int tl = 0; tl < 4; ++tl) {
            const float dec = __expf(-0.6065306597126334f * sigmoidf_(wf[tl]));
            const float av = sigmoidf_(af[tl]);
            float kk = k[tl] * kkp;
            const float nrm = wave_sum(kk * kk);
            kk = kk / fmaxf(sqrtf(nrm), 1e-12f);
            const float kp = k[tl] * (1.f + (av - 1.f) * kap);
            const float bon = wave_sum(r[tl] * kp * rkp);
            VW[tl * 64 + c] = dec; VA[tl * 64 + c] = -kk; VB[tl * 64 + c] = kk * av; VK[tl * 64 + c] = kp; VR[tl * 64 + c] = r[tl]; VV[tl * 64 + c] = v[tl];
            if (c == 0) BON[tl] = bon;
        }
        LDS_WAIT();
        float S[64];
        { const f32x4* sp = (const f32x4*)(F.in[3] + ((size_t)(sb * NH + h) * 64 + c) * 64);
#pragma unroll
          for (int k4 = 0; k4 < 16; ++k4) { const f32x4 t = sp[k4]; S[4 * k4] = t[0]; S[4 * k4 + 1] = t[1]; S[4 * k4 + 2] = t[2]; S[4 * k4 + 3] = t[3]; } }
#pragma unroll 1
        for (int tl = 0; tl < 4; ++tl) { const float vv = VV[tl * 64 + c]; float y; WKV_STEP(S, VW + tl * 64, VA + tl * 64, VB + tl * 64, VK + tl * 64, VR + tl * 64, vv, y); VY[tl * 64 + c] = y; }
        { f32x4* sp = (f32x4*)(F.out + OFF_SWKV + ((size_t)(sb * NH + h) * 64 + c) * 64);
#pragma unroll
          for (int k4 = 0; k4 < 16; ++k4) sp[k4] = (f32x4){S[4 * k4], S[4 * k4 + 1], S[4 * k4 + 2], S[4 * k4 + 3]}; }
        const float lng = F.in[15][hc + c], lnb = F.in[16][hc + c];
        LDS_WAIT();
#pragma unroll 1
        for (int tl = 0; tl < 4; ++tl) {
            const float yv = VY[tl * 64 + c];
            const float mean = wave_sum(yv) * (1.f / 64.f); const float dy = yv - mean;
            const float var = wave_sum(dy * dy) * (1.f / 64.f);
            const float yn = dy * rsqrtf(var + 64e-5f) * lng + lnb;
            const float z = bf2f(P[(size_t)(PA_ROWS + sb * 4 + tl) * RWIN + SHIFTC + hc + c]);
            const float o = (yn + BON[tl] * VV[tl * 64 + c]) * (z * sigmoidf_(z));
            const float o2 = __shfl_down(o, 1);
            if (!(c & 1)) *(unsigned*)(O + (size_t)(MP + sb * 4 + tl) * E + hc + c) = pk2(o, o2);
        }
    }
}

constexpr int GP = 136;
__device__ __forceinline__ void phase_gate(Frame& F) {
    bf16_t* P2 = (bf16_t*)(F.ws + WS_PROJ2);
    const float* vsum = F.misc + MI_VSUM; const float* vsq = F.misc + MI_VSQ;
    bf16_t* WM = (bf16_t*)F.lds; bf16_t* VT = WM + 128 * GP;
    const int tid = F.tid, lane = F.lane, fr = lane & 15, fq = lane >> 4;
    for (int u = F.bid; u < 1024; u += F.G) {
        const int bc = u >> 3, g = u & 7, row0 = bc * 128;
        __syncthreads();
        for (int idx = tid; idx < 128 * 32; idx += NTHREADS) { const int t = idx >> 5, s4 = (idx & 31) * 4;
            const f32x4 w = *(const f32x4*)(F.in[21] + ((size_t)g * 128 + t) * 128 + s4);
            u32x2 o; o.x = pk2(s4 <= t ? w[0] : 0.f, s4 + 1 <= t ? w[1] : 0.f); o.y = pk2(s4 + 2 <= t ? w[2] : 0.f, s4 + 3 <= t ? w[3] : 0.f);
            *(u32x2*)(WM + t * GP + s4) = o; }
        for (int idx = tid; idx < 128 * 32; idx += NTHREADS) { const int s = (idx & 15) + 16 * (idx >> 9), d8 = ((idx >> 4) & 31) * 8, row = row0 + s;
            const float mean = vsum[row] * (1.f / E); const float rstd = rsqrtf(vsq[row] * (1.f / E) - mean * mean + 1e-5f);
            const u32x4 raw = *(const u32x4*)(P2 + (size_t)row * GMIN + E + g * 256 + d8);
            const float* vg = F.in[19] + g * 256 + d8; const float* vb = F.in[20] + g * 256 + d8;
            float x[8] = {bflo(raw.x), bfhi(raw.x), bflo(raw.y), bfhi(raw.y), bflo(raw.z), bfhi(raw.z), bflo(raw.w), bfhi(raw.w)};
#pragma unroll
            for (int e = 0; e < 8; ++e) { const float vn = (x[e] - mean) * rstd * vg[e] + vb[e]; VT[(d8 + e) * GP + s] = (bf16_t)(pk2(vn, 0.f) & 0xffffu); } }
        __syncthreads();
        const int t0 = F.wave * 16;
        f32x4 acc[16];
#pragma unroll
        for (int i = 0; i < 16; ++i) acc[i] = (f32x4){0.f, 0.f, 0.f, 0.f};
        const int nkb = (t0 + 15) / 32 + 1;
        for (int kb = 0; kb < nkb; ++kb) {
            const bf16x8 yf = *(const bf16x8*)(WM + (t0 + fr) * GP + kb * 32 + fq * 8);
#pragma unroll
            for (int dt = 0; dt < 16; ++dt) { const bf16x8 xf = *(const bf16x8*)(VT + (dt * 16 + fr) * GP + kb * 32 + fq * 8);
                acc[dt] = __builtin_amdgcn_mfma_f32_16x16x32_bf16(xf, yf, acc[dt], 0, 0, 0); }
        }
        const int t = t0 + fr, row = row0 + t; const float bias = F.in[22][g * 128 + t];
        bf16_t* prow = P2 + (size_t)row * GMIN + g * 256;
        u32x2 uu_[16], zz_[16];
#pragma unroll
        for (int dt = 0; dt < 16; ++dt) { const int d = dt * 16 + 4 * fq; uu_[dt] = *(const u32x2*)(prow + d); zz_[dt] = *(const u32x2*)(prow + 2 * E + d); }
#pragma unroll
        for (int dt = 0; dt < 16; ++dt) { const int d = dt * 16 + 4 * fq;
            const u32x2 uu = uu_[dt]; const u32x2 zz = zz_[dt];
            const float o0 = bflo(uu.x) * (acc[dt][0] + bias) * bflo(zz.x), o1 = bfhi(uu.x) * (acc[dt][1] + bias) * bfhi(zz.x);
            const float o2 = bflo(uu.y) * (acc[dt][2] + bias) * bflo(zz.y), o3 = bfhi(uu.y) * (acc[dt][3] + bias) * bfhi(zz.y);
            u32x2 o; o.x = pk2(o0, o1); o.y = pk2(o2, o3); *(u32x2*)(prow + d) = o; }
    }
    float* sv = F.out + OFF_SV;
    for (int it = F.bid * NTHREADS + tid; it < 128 * E; it += F.G * NTHREADS) {
        const int sb = it >> 11, col = it & 2047, g = col >> 8;
        const float vg = F.in[19][col], vb = F.in[20][col];
        float vn[4];
#pragma unroll
        for (int t = 0; t < 4; ++t) { const int row = MP + sb * 4 + t; const float mean = vsum[row] * (1.f / E); const float rstd = rsqrtf(vsq[row] * (1.f / E) - mean * mean + 1e-5f);
            vn[t] = (bf2f(P2[(size_t)row * GMIN + E + col]) - mean) * rstd * vg + vb; sv[((size_t)sb * 4 + t) * E + col] = vn[t]; }
#pragma unroll
        for (int t = 0; t < 4; ++t) { const int row = MP + sb * 4 + t; float mx = F.in[22][g * 128 + t];
#pragma unroll
            for (int s = 0; s <= t; ++s) mx += F.in[21][((size_t)g * 128 + t) * 128 + s] * vn[s];
            bf16_t* pu = P2 + (size_t)row * GMIN + col; const float o = bf2f(pu[0]) * mx * bf2f(pu[2 * E]);
            pu[0] = (bf16_t)(pk2(o, 0.f) & 0xffffu); }
    }
}

__device__ __forceinline__ void phase_final(Frame& F) {
    const float* ss2 = F.misc + MI_SS2; const float* gf = F.in[5];
    const int gw = F.bid * NWAVES + F.wave, NGW = F.G * NWAVES;
    f32x4 gv[4];
#pragma unroll
    for (int j = 0; j < 4; ++j) gv[j] = ((const f32x4*)gf)[F.lane + 64 * j];
    for (int row = gw; row < MTOT; row += NGW) {
        const float s = rsqrtf(ss2[row] * (1.f / D) + 1e-6f);
        f32x4* y = (f32x4*)(F.out + OFF_Y + (size_t)row * D) + F.lane;
#pragma unroll
        for (int j = 0; j < 4; ++j) { f32x4 v = y[64 * j]; v = v * s * gv[j]; y[64 * j] = v; }
    }
}

__global__ void __launch_bounds__(NTHREADS, 2) fwd_kernel(Params p) {
    extern __shared__ __attribute__((aligned(16))) unsigned char lds[];
    Frame F;
    F.lds = lds; F.tid = threadIdx.x; F.lane = F.tid & 63; F.wave = __builtin_amdgcn_readfirstlane(F.tid >> 6); F.G = gridDim.x; F.bid = blockIdx.x;
    F.in = p.in; F.out = p.out; F.ws = p.ws; F.misc = (float*)(p.ws + WS_MISC);
    const int lo = p.ph_lo, hi = p.ph_hi;
    if (lo < -1) { __threadfence(); cg::this_grid().sync(); }
#ifndef PHASE_MASK
#define PHASE_MASK 0x3ff
#endif
#define IN(k) (((PHASE_MASK >> (k)) & 1) && lo <= (k) && (k) < hi)
    volatile LAS unsigned* xst = (volatile LAS unsigned*)((LAS unsigned char*)lds + (LDS_BYTES - 16));
    if (F.tid == 0) { xst[0] = 0u; xst[1] = 0u; }
    __syncthreads();
    XcdBarrier gbar = xcd_barrier_post((unsigned*)(p.ws + WS_BAR), xst);
#define SEAM(k) do { if (IN(k) && IN((k) + 1)) { xcd_barrier(gbar); } } while (0)
    bf16_t* XB = (bf16_t*)(F.out + OFF_SWKV);
    bf16_t* PROJH = (bf16_t*)(F.ws + WS_PROJH);
#ifdef PROBE_LO
    unsigned long long* tsb = (unsigned long long*)(p.ws + WS_BAR + 32768);
#define TS(k) do { if (F.bid == 0 && F.tid == 0) tsb[k] = __builtin_amdgcn_s_memrealtime(); } while (0)
#else
#define TS(k) do {} while (0)
#endif
    TS(0);
    if (IN(0)) { phase_prologue(F); }
    SEAM(0); TS(1);
    if (IN(1)) {
        pg8::Gemm g{XB, (const bf16_t*)(F.ws + WS_W1T), PA_ROWS, RWIN_PAD, D, D}; pg8::StaticOrder S; S.init(PA_ROWS, RWIN_PAD, F.G, F.bid);
        Epi1 E1{PROJH, F.misc + MI_RS0, 0, F.out + OFF_PSHIFT, F.out + OFF_SSHIFT, F.misc + MI_CARRY};
        pg8::gemm_phase<Epi1>((LAS unsigned char*)lds, g, S, E1);
    }
    SEAM(1); TS(2);
    if (IN(2)) { scan_prompt(F, 0); }
    SEAM(2); TS(3);
    if (IN(3)) {
        pg8::Gemm g{XB + (size_t)PA_ROWS * D, (const bf16_t*)(F.ws + WS_W1T), PB_ROWS, RWIN_PAD, D, D}; pg8::StaticOrder S; S.init(PB_ROWS, RWIN_PAD, F.G, F.bid);
        Epi1 E1{PROJH, F.misc + MI_RS0 + PA_ROWS, 1, F.out + OFF_PSHIFT, F.out + OFF_SSHIFT, F.misc + MI_CARRY};
        pg8::gemm_phase<Epi1>((LAS unsigned char*)lds, g, S, E1);
    }
    SEAM(3); TS(4);
    if (IN(4)) { scan_prompt(F, 1); scan_samples(F); }
    SEAM(4); TS(5);
    if (IN(5)) {
        pg8::Gemm g{(const bf16_t*)(F.ws + WS_O), (const bf16_t*)(F.ws + WS_W2T), MTOT, D, E, E}; pg8::StaticOrder S; S.init(MTOT, D, F.G, F.bid);
        Epi2 E2{F.in[0], F.in[1], F.out + OFF_Y, (bf16_t*)(F.ws + WS_X1B), F.misc + MI_SS1};
        pg8::gemm_phase<Epi2>((LAS unsigned char*)lds, g, S, E2);
#ifdef PROBE_KLOOP
        __syncthreads();
        Epi2 EN{F.in[0], F.in[1], F.out + OFF_Y, (bf16_t*)(F.ws + WS_X1B), nullptr};
        pg8::gemm_phase<Epi2>((LAS unsigned char*)lds, g, S, EN);
#endif
    }
    SEAM(5); TS(6);
    if (IN(6)) {
        pg8::Gemm g{(const bf16_t*)(F.ws + WS_X1B), (const bf16_t*)(F.ws + WS_W3T), MTOT, GMIN, D, D}; pg8::StaticOrder S; S.init(MTOT, GMIN, F.G, F.bid);
        Epi3 E3{(bf16_t*)(F.ws + WS_PROJ2), F.misc + MI_SS1, F.misc + MI_VSUM, F.misc + MI_VSQ};
        pg8::gemm_phase<Epi3>((LAS unsigned char*)lds, g, S, E3);
    }
    SEAM(6); TS(7);
    if (IN(7)) { phase_gate(F); }
    SEAM(7); TS(8);
    if (IN(8)) {
        pg8::Gemm g{(const bf16_t*)(F.ws + WS_PROJ2), (const bf16_t*)(F.ws + WS_W4T), MTOT, D, E, GMIN}; pg8::StaticOrder S; S.init(MTOT, D, F.G, F.bid);
        Epi4 E4{F.out + OFF_Y, F.misc + MI_SS2, (const bf16_t*)(F.ws + WS_X1B)};
        pg8::gemm_phase<Epi4>((LAS unsigned char*)lds, g, S, E4);
    }
    SEAM(8); TS(9);
    if (IN(9)) { phase_final(F); }
#ifdef PROBE_LO
    if (F.bid == 0 && F.tid == 0) { const unsigned long long tend = __builtin_amdgcn_s_memrealtime(); tsb[10] = tend; __threadfence();
        const unsigned long long dt = tsb[PROBE_HI] - tsb[PROBE_LO];
        while (__builtin_amdgcn_s_memrealtime() - tend < dt) __builtin_amdgcn_s_sleep(8); }
#endif
#undef IN
#undef SEAM
}

constexpr int NPHASES = 10;
extern "C" void kernel_launch(void* const* d_in, const int* in_sizes, int n_in, void* d_out, int out_size, void* d_ws, size_t ws_size, hipStream_t stream) {
    static int grid = 0;
    if (grid == 0) {
        int dev = 0, cus = 0, per_cu = 0;
        hipGetDevice(&dev);
        hipDeviceGetAttribute(&cus, hipDeviceAttributeMultiprocessorCount, dev);
        hipFuncSetAttribute((const void*)fwd_kernel, hipFuncAttributeMaxDynamicSharedMemorySize, LDS_BYTES);
        hipOccupancyMaxActiveBlocksPerMultiprocessor(&per_cu, (const void*)fwd_kernel, NTHREADS, LDS_BYTES);
        if (per_cu < 1) per_cu = 1;
        grid = cus * per_cu;
        if (grid > 256) grid = 256;
        (void)hipGetLastError();
    }
    Params p{};
    for (int i = 0; i < 24; ++i) p.in[i] = (const float*)d_in[i];
    p.out = (float*)d_out; p.ws = (unsigned char*)d_ws;
#if MK_ONE_LAUNCH
    p.ph_lo = 0; p.ph_hi = NPHASES;
    (void)hipMemsetAsync((unsigned char*)d_ws + WS_BAR, 0, 16384, stream);
    void* args[] = {&p};
    hipError_t e = hipLaunchCooperativeKernel((const void*)fwd_kernel, dim3(grid), dim3(NTHREADS), args, LDS_BYTES, stream);
    if (e != hipSuccess) fprintf(stderr, "cooperative launch failed: %s (grid %d)\n", hipGetErrorString(e), grid);
#else
    for (int ph = 0; ph < NPHASES; ++ph) {
        p.ph_lo = ph; p.ph_hi = ph + 1;
        hipLaunchKernelGGL(fwd_kernel, dim3(grid), dim3(NTHREADS), LDS_BYTES, stream, p);
    }
#endif
}
```

```cpp
#include <hip/hip_runtime.h>
#include <hip/hip_cooperative_groups.h>
#include <cstdio>
namespace cg = cooperative_groups;

#ifndef MK_ONE_LAUNCH
#define MK_ONE_LAUNCH 1
#endif

#define LAS __attribute__((address_space(3)))
typedef unsigned short bf16_t;
typedef short bf16x8 __attribute__((ext_vector_type(8)));
typedef float f32x4 __attribute__((ext_vector_type(4)));
typedef unsigned u32x2 __attribute__((ext_vector_type(2)));
typedef unsigned u32x4 __attribute__((ext_vector_type(4)));

constexpr int D = 1024, E = 2048, NH = 32, SHIFTC = 6272, RWIN = 8320, RWIN_PAD = 8448, GMIN = 6144;
constexpr int MP = 16384, MS = 512, MTOT = 16896;
constexpr int PA_ROWS = 8192, PB_ROWS = 8704;
constexpr int NTHREADS = 512, NWAVES = 8;
constexpr int LDS_BYTES = 160768;
constexpr size_t OFF_Y = 0, OFF_PSHIFT = 17301504, OFF_PWKV = 17351680, OFF_SSHIFT = 18400256, OFF_SWKV = 19203072, OFF_SV = 35980288;
constexpr size_t MiB = 1u << 20;
constexpr size_t WS_O = 0, WS_PROJH = 66 * MiB, WS_W1T = 204 * MiB + 512 * 1024, WS_X1B = 198 * MiB, WS_PROJ2 = 0;
constexpr size_t WS_BAR = 255 * MiB;
constexpr size_t WS_W3T = 231 * MiB, WS_W4T = 243 * MiB, WS_W2T = 247 * MiB, WS_MISC = 251 * MiB;
constexpr int MI_RS0 = 0, MI_SS1 = 16896, MI_VSUM = 2 * 16896, MI_VSQ = 3 * 16896, MI_SS2 = 4 * 16896, MI_CARRY = 5 * 16896;

struct Params { const float* in[24]; float* out; unsigned char* ws; int ph_lo, ph_hi; };

__device__ __forceinline__ unsigned pk2(float lo, float hi) { unsigned r; asm("v_cvt_pk_bf16_f32 %0, %1, %2" : "=v"(r) : "v"(lo), "v"(hi)); return r; }
__device__ __forceinline__ float bf2f(bf16_t b) { return __uint_as_float(((unsigned)b) << 16); }
__device__ __forceinline__ float bflo(unsigned u) { return __uint_as_float(u << 16); }
__device__ __forceinline__ float bfhi(unsigned u) { return __uint_as_float(u & 0xffff0000u); }
__device__ __forceinline__ float dpp_f(float v, const int ctrl_sel) {
    int r;
    if (ctrl_sel == 0) r = __builtin_amdgcn_update_dpp(0, __float_as_int(v), 0xB1, 0xf, 0xf, true);
    else if (ctrl_sel == 1) r = __builtin_amdgcn_update_dpp(0, __float_as_int(v), 0x4E, 0xf, 0xf, true);
    else if (ctrl_sel == 2) r = __builtin_amdgcn_update_dpp(0, __float_as_int(v), 0x141, 0xf, 0xf, true);
    else r = __builtin_amdgcn_update_dpp(0, __float_as_int(v), 0x140, 0xf, 0xf, true);
    return __int_as_float(r);
}
__device__ __forceinline__ float wave_sum(float v) {
    v += dpp_f(v, 0); v += dpp_f(v, 1); v += dpp_f(v, 2); v += dpp_f(v, 3);
    const int iv = __float_as_int(v);
    const float a = __int_as_float(__builtin_amdgcn_readlane(iv, 0)), b = __int_as_float(__builtin_amdgcn_readlane(iv, 16));
    const float c = __int_as_float(__builtin_amdgcn_readlane(iv, 32)), d = __int_as_float(__builtin_amdgcn_readlane(iv, 48));
    return (a + b) + (c + d);
}
#define LBAR() do { asm volatile("s_waitcnt lgkmcnt(0)" ::: "memory"); __builtin_amdgcn_s_barrier(); asm volatile("" ::: "memory"); } while (0)
__device__ __forceinline__ float rcp_(float x) { return __builtin_amdgcn_rcpf(x); }
__device__ __forceinline__ float sigmoidf_(float x) { return rcp_(1.f + __expf(-x)); }
__device__ __forceinline__ float tanh_(float x) { return 1.f - 2.f * rcp_(1.f + __expf(2.f * x)); }
__device__ __forceinline__ float gelu_tanh(float x) { const float u = 1.5957691216057308f * (x + 0.044715f * x * x * x); return x * rcp_(1.f + __expf(-u)); }
#define LDS_WAIT() asm volatile("s_waitcnt lgkmcnt(0)" ::: "memory")

namespace pg8 {
constexpr int BM = 256, BK = 64, HALF = 128, HTB = HALF * BK * 2, STAGE_BYTES = 8 * HTB, NXCD = 8, WGM = 8;
__host__ __device__ __forceinline__ int lds_byte(int r, int c) { const int st = (r >> 4) * 2 + (c >> 5), rr = r & 15, cc = c & 31, ob = rr * 64 + cc * 2; return st * 1024 + (ob ^ (((ob >> 9) & 1) << 5)); }
__host__ __device__ __forceinline__ void stage_rc(int b, int& R, int& C) { const int st = b / 1024, sb = b % 1024, swz = sb ^ (((sb >> 9) & 1) << 5); R = (st >> 1) * 16 + swz / 64; C = (st & 1) * 32 + (swz % 64) / 2; }
__host__ __device__ __forceinline__ int perm32(int rho) { const int n = rho >> 4, i = rho & 15; return 8 * (i >> 2) + 4 * n + (i & 3); }
struct Unit { int pm, pn; };
struct Gemm { const bf16_t* A; const bf16_t* Bt; int M, N, K, lda; };
struct StaticOrder {
    int nM, nN, nwg, G, c;
    __device__ void init(int M, int N, int G_, int c_) { nM = M / BM; nN = N / BM; nwg = nM * nN; G = G_; c = c_; }
    __device__ bool next(int i, Unit& u) const {
        const long L = (long)i * G + c; if (L >= nwg) return false;
        int wgid = (int)L; { const int q = nwg / NXCD, r = nwg % NXCD, xcd = wgid % NXCD, off = wgid / NXCD; wgid = (xcd < r ? xcd * (q + 1) : r * (q + 1) + (xcd - r) * q) + off; }
        const int nig = WGM * nN, gid = wgid / nig, fm = gid * WGM, gsz = (nM - fm) < WGM ? (nM - fm) : WGM;
        u.pm = fm + ((wgid % nig) % gsz); u.pn = (wgid % nig) / gsz; return true;
    }
};
template <class Epi>
__device__ __forceinline__ void gemm_phase(LAS unsigned char* lds, const Gemm g, const StaticOrder& S, const Epi& E) {
    const int tid = threadIdx.x, wid = __builtin_amdgcn_readfirstlane(tid >> 6), lane = tid & 63, wr = wid >> 2, wc = wid & 3, fr = lane & 15, fq = lane >> 4;
    const int K = g.K, nt = K / BK, lda = g.lda;
    unsigned voffA[2], voffB[2];
#pragma unroll
    for (int i = 0; i < 2; ++i) { int R, C; stage_rc(tid * 16 + i * 8192, R, C); const int Rb = Epi::PERM ? ((R & ~31) + perm32(R & 31)) : R; voffA[i] = (unsigned)(R * lda + C) * 2u; voffB[i] = (unsigned)(Rb * K + C) * 2u; }
    const size_t kstep = (size_t)(BK * 2);
    const size_t hstepA = (size_t)HALF * lda * 2, hstepB = (size_t)HALF * K * 2;
    const size_t tstepA = 2 * hstepA, tstepB = 2 * hstepB;
    const unsigned ldsw = (unsigned)wid * 1024u;
    const int aoff = lds_byte(wr * 64 + fr, fq * 8), boff = lds_byte(wc * 32 + fr, fq * 8);
#define PG8_SA(b, h) (((b) * 2 + (h)) * HTB)
#define PG8_SB(b, h) ((4 + (b) * 2 + (h)) * HTB)
#define PG8_STAGE(bufoff, gbase, voff) do { _Pragma("unroll") for (int _i = 0; _i < 2; ++_i) \
        __builtin_amdgcn_global_load_lds((const unsigned*)((const char*)(gbase) + (voff)[_i]), (LAS unsigned*)(lds + (bufoff) + ldsw + _i * 8192), 16, 0, 0); } while (0)
#define PG8_LDA(dst, b, h) do { _Pragma("unroll") for (int m = 0; m < 4; ++m) _Pragma("unroll") for (int k = 0; k < 2; ++k) dst[m][k] = *(const LAS bf16x8*)(lds + PG8_SA(b, h) + aoff + m * 2048 + k * 1024); } while (0)
#define PG8_LDB(dst, b, h) do { _Pragma("unroll") for (int n = 0; n < 2; ++n) _Pragma("unroll") for (int k = 0; k < 2; ++k) dst[n][k] = *(const LAS bf16x8*)(lds + PG8_SB(b, h) + boff + n * 2048 + k * 1024); } while (0)
#define PG8_MMA(ai, bj, At, Bt) do { __builtin_amdgcn_s_setprio(1); _Pragma("unroll") for (int m = 0; m < 4; ++m) _Pragma("unroll") for (int n = 0; n < 2; ++n) _Pragma("unroll") for (int k = 0; k < 2; ++k) \
        acc[ai][bj][m][n] = __builtin_amdgcn_mfma_f32_16x16x32_bf16(Bt[n][k], At[m][k], acc[ai][bj][m][n], 0, 0, 0); __builtin_amdgcn_s_setprio(0); } while (0)
#define PG8_WAIT_V(n) asm volatile("s_waitcnt vmcnt(" #n ")" ::: "memory")
#define PG8_WAIT_L(n) asm volatile("s_waitcnt lgkmcnt(" #n ")" ::: "memory")
#define PG8_BAR __builtin_amdgcn_s_barrier()
#define PG8_SCHED __builtin_amdgcn_sched_barrier(0)
    Unit cur, nxt; int ui = 0;
    if (!S.next(0, cur)) return;
    f32x4 acc[2][2][4][2];
#pragma unroll
    for (int a = 0; a < 2; ++a)
#pragma unroll
        for (int b = 0; b < 2; ++b)
#pragma unroll
            for (int m = 0; m < 4; ++m)
#pragma unroll
                for (int n = 0; n < 2; ++n) acc[a][b][m][n] = (f32x4){0.f, 0.f, 0.f, 0.f};
    bf16x8 At[4][2], B0[2][2], B1[2][2];
    const char* cA = (const char*)g.A + (size_t)cur.pm * tstepA; const char* cB = (const char*)g.Bt + (size_t)cur.pn * tstepB;
    PG8_STAGE(PG8_SB(0, 0), cB, voffB); PG8_STAGE(PG8_SA(0, 0), cA, voffA); PG8_STAGE(PG8_SB(0, 1), cB + hstepB, voffB); PG8_STAGE(PG8_SA(0, 1), cA + hstepA, voffA);
    if (wr == 1) PG8_BAR;
    PG8_WAIT_V(4); PG8_BAR;
    PG8_STAGE(PG8_SB(1, 0), cB + kstep, voffB); PG8_STAGE(PG8_SA(1, 0), cA + kstep, voffA); PG8_STAGE(PG8_SB(1, 1), cB + hstepB + kstep, voffB);
    PG8_WAIT_V(6); PG8_BAR;
    for (;;) {
        const bool has_next = S.next(ui + 1, nxt);
        const char* nA = has_next ? (const char*)g.A + (size_t)nxt.pm * tstepA : cA; const char* nB = has_next ? (const char*)g.Bt + (size_t)nxt.pn * tstepB : cB;
        for (int t = 0; t < nt; t += 2) {
            const bool last = (t == nt - 2);
            const char* a1 = cA + (size_t)(t + 1) * kstep;
            const char* a2 = last ? nA : cA + (size_t)(t + 2) * kstep; const char* b2 = last ? nB : cB + (size_t)(t + 2) * kstep;
            const char* a3 = a2 + kstep; const char* b3 = b2 + kstep;
            PG8_LDB(B0, 0, 0); PG8_SCHED; PG8_LDA(At, 0, 0); PG8_STAGE(PG8_SA(1, 1), a1 + hstepA, voffA);
            PG8_WAIT_L(8); PG8_BAR; PG8_WAIT_L(0); PG8_MMA(0, 0, At, B0); PG8_BAR; PG8_SCHED;
            PG8_LDB(B1, 0, 1); PG8_STAGE(PG8_SB(0, 0), b2, voffB);
            PG8_BAR; PG8_WAIT_L(0); PG8_MMA(0, 1, At, B1); PG8_BAR;
            PG8_LDA(At, 0, 1); PG8_STAGE(PG8_SA(0, 0), a2, voffA);
            PG8_BAR; PG8_WAIT_L(0); PG8_MMA(1, 0, At, B0); PG8_BAR; PG8_SCHED;
            PG8_STAGE(PG8_SB(0, 1), b2 + hstepB, voffB);
            PG8_WAIT_V(6); PG8_BAR; PG8_MMA(1, 1, At, B1); PG8_BAR;
            PG8_LDB(B0, 1, 0); PG8_SCHED; PG8_LDA(At, 1, 0); PG8_STAGE(PG8_SA(0, 1), a2 + hstepA, voffA);
            PG8_WAIT_L(8); PG8_BAR; PG8_WAIT_L(0); PG8_MMA(0, 0, At, B0); PG8_BAR; PG8_SCHED;
            PG8_LDB(B1, 1, 1); PG8_STAGE(PG8_SB(1, 0), b3, voffB);
            PG8_BAR; PG8_WAIT_L(0); PG8_MMA(0, 1, At, B1); PG8_BAR;
            PG8_LDA(At, 1, 1); PG8_STAGE(PG8_SA(1, 0), a3, voffA);
            PG8_BAR; PG8_WAIT_L(0); PG8_MMA(1, 0, At, B0); PG8_BAR; PG8_SCHED;
            PG8_STAGE(PG8_SB(1, 1), b3 + hstepB, voffB);
            PG8_WAIT_V(6); PG8_BAR; PG8_MMA(1, 1, At, B1); PG8_BAR;
        }
        E(acc, cur, wr, wc, fr, fq);
        if (!has_next) break;
#pragma unroll
        for (int a = 0; a < 2; ++a)
#pragma unroll
            for (int b = 0; b < 2; ++b)
#pragma unroll
                for (int m = 0; m < 4; ++m)
#pragma unroll
                    for (int n = 0; n < 2; ++n) acc[a][b][m][n] = (f32x4){0.f, 0.f, 0.f, 0.f};
        cur = nxt; cA = nA; cB = nB; ++ui;
    }
    PG8_WAIT_V(0);
    if (wr == 0) PG8_BAR;
    PG8_BAR;
#undef PG8_SA
#undef PG8_SB
#undef PG8_STAGE
#undef PG8_LDA
#undef PG8_LDB
#undef PG8_MMA
#undef PG8_WAIT_V
#undef PG8_WAIT_L
#undef PG8_BAR
#undef PG8_SCHED
}
}

#define EPI_ROW(u, ai, m) ((u).pm * 256 + (ai) * 128 + wr * 64 + (m) * 16 + fr)
#define EPI_COL(u, bj, n) ((u).pn * 256 + (bj) * 128 + wc * 32 + (n) * 16 + 4 * fq)

#define EPI_COLP(u, bj) ((u).pn * 256 + (bj) * 128 + wc * 32 + 8 * fq)
struct Epi1 {
    static constexpr bool PERM = true;
    bf16_t* P; const float* rs; int pass; float* pshift; float* sshift; float* carry;
    __device__ __forceinline__ void operator()(const f32x4 (&acc)[2][2][4][2], const pg8::Unit& u, int wr, int wc, int fr, int fq) const {
        float rsv[2][4];
#pragma unroll
        for (int ai = 0; ai < 2; ++ai)
#pragma unroll
            for (int m = 0; m < 4; ++m) rsv[ai][m] = rs[EPI_ROW(u, ai, m)];
#pragma unroll
        for (int ai = 0; ai < 2; ++ai)
#pragma unroll
            for (int m = 0; m < 4; ++m) {
                const int row = EPI_ROW(u, ai, m); const float s = rsv[ai][m];
                float* sdst = nullptr;
                if (pass == 0) { if ((row & 1023) == 1023) sdst = carry + (size_t)(row >> 10) * SHIFTC; }
                else { if (row < 8192) { if ((row & 1023) == 1023) sdst = pshift + (size_t)(row >> 10) * SHIFTC; } else { const int q = row - 8192; if ((q & 3) == 3) sdst = sshift + (size_t)(q >> 2) * SHIFTC; } }
                bf16_t* prow = P + (size_t)row * RWIN;
#pragma unroll
                for (int bj = 0; bj < 2; ++bj) {
                    const int col = EPI_COLP(u, bj);
                    if (col < RWIN) {
                        const f32x4 v0 = acc[ai][bj][m][0] * s, v1 = acc[ai][bj][m][1] * s;
                        u32x4 o; o.x = pk2(v0[0], v0[1]); o.y = pk2(v0[2], v0[3]); o.z = pk2(v1[0], v1[1]); o.w = pk2(v1[2], v1[3]);
                        *(u32x4*)(prow + col) = o;
                        if (sdst && col < SHIFTC) { *(f32x4*)(sdst + col) = v0; *(f32x4*)(sdst + col + 4) = v1; }
                    }
                }
            }
    }
};
struct Epi2 {
    static constexpr bool PERM = true;
    const float* xp; const float* xs; float* Y; bf16_t* XB; float* ss;
    __device__ __forceinline__ void operator()(const f32x4 (&acc)[2][2][4][2], const pg8::Unit& u, int wr, int wc, int fr, int fq) const {
#pragma unroll
        for (int ai = 0; ai < 2; ++ai) {
            f32x4 xv[4][2][2];
#pragma unroll
            for (int m = 0; m < 4; ++m) { const int row = EPI_ROW(u, ai, m);
                const float* xr = row < MP ? xp + (size_t)row * D : xs + (size_t)(row - MP) * D;
#pragma unroll
                for (int bj = 0; bj < 2; ++bj) { xv[m][bj][0] = *(const f32x4*)(xr + EPI_COLP(u, bj)); xv[m][bj][1] = *(const f32x4*)(xr + EPI_COLP(u, bj) + 4); } }
#pragma unroll
            for (int m = 0; m < 4; ++m) {
                const int row = EPI_ROW(u, ai, m);
                float part = 0.f;
#pragma unroll
                for (int bj = 0; bj < 2; ++bj) {
                    const int col = EPI_COLP(u, bj);
                    const f32x4 v0 = acc[ai][bj][m][0] + xv[m][bj][0], v1 = acc[ai][bj][m][1] + xv[m][bj][1];
                    u32x4 o; o.x = pk2(v0[0], v0[1]); o.y = pk2(v0[2], v0[3]); o.z = pk2(v1[0], v1[1]); o.w = pk2(v1[2], v1[3]);
                    *(u32x4*)(XB + (size_t)row * D + col) = o;
                    part += ((v0[0] * v0[0] + v0[1] * v0[1]) + (v0[2] * v0[2] + v0[3] * v0[3])) + ((v1[0] * v1[0] + v1[1] * v1[1]) + (v1[2] * v1[2] + v1[3] * v1[3]));
                }
                part += __shfl_xor(part, 16); part += __shfl_xor(part, 32);
                if (fq == 0 && ss) atomicAdd(ss + row, part);
            }
        }
    }
};
struct Epi3 {
    static constexpr bool PERM = true;
    bf16_t* P; const float* ss1; float* vsum; float* vsq;
    __device__ __forceinline__ void operator()(const f32x4 (&acc)[2][2][4][2], const pg8::Unit& u, int wr, int wc, int fr, int fq) const {
        const int region = u.pn >> 3;
        float sv8[2][4];
#pragma unroll
        for (int ai = 0; ai < 2; ++ai)
#pragma unroll
            for (int m = 0; m < 4; ++m) sv8[ai][m] = ss1[EPI_ROW(u, ai, m)];
#pragma unroll
        for (int ai = 0; ai < 2; ++ai)
#pragma unroll
            for (int m = 0; m < 4; ++m) {
                const int row = EPI_ROW(u, ai, m);
                const float s = rsqrtf(sv8[ai][m] * (1.f / D) + 1e-6f);
                float p1 = 0.f, p2 = 0.f;
#pragma unroll
                for (int bj = 0; bj < 2; ++bj) {
                    const int col = EPI_COLP(u, bj);
                    f32x4 v[2] = {acc[ai][bj][m][0] * s, acc[ai][bj][m][1] * s};
#pragma unroll
                    for (int n = 0; n < 2; ++n) {
                        if (region == 2) { v[n][0] = v[n][0] * sigmoidf_(v[n][0]); v[n][1] = v[n][1] * sigmoidf_(v[n][1]); v[n][2] = v[n][2] * sigmoidf_(v[n][2]); v[n][3] = v[n][3] * sigmoidf_(v[n][3]); }
                        else { v[n][0] = gelu_tanh(v[n][0]); v[n][1] = gelu_tanh(v[n][1]); v[n][2] = gelu_tanh(v[n][2]); v[n][3] = gelu_tanh(v[n][3]); }
                        if (region == 1) { p1 += (v[n][0] + v[n][1]) + (v[n][2] + v[n][3]); p2 += (v[n][0] * v[n][0] + v[n][1] * v[n][1]) + (v[n][2] * v[n][2] + v[n][3] * v[n][3]); }
                    }
                    u32x4 o; o.x = pk2(v[0][0], v[0][1]); o.y = pk2(v[0][2], v[0][3]); o.z = pk2(v[1][0], v[1][1]); o.w = pk2(v[1][2], v[1][3]);
                    *(u32x4*)(P + (size_t)row * GMIN + col) = o;
                }
                if (region == 1) {
                    p1 += __shfl_xor(p1, 16); p1 += __shfl_xor(p1, 32); p2 += __shfl_xor(p2, 16); p2 += __shfl_xor(p2, 32);
                    if (fq == 0) { atomicAdd(vsum + row, p1); atomicAdd(vsq + row, p2); }
                }
            }
    }
};
struct Epi4 {
    static constexpr bool PERM = true;
    float* Y; float* ss; const bf16_t* XB;
    __device__ __forceinline__ void operator()(const f32x4 (&acc)[2][2][4][2], const pg8::Unit& u, int wr, int wc, int fr, int fq) const {
#pragma unroll
        for (int ai = 0; ai < 2; ++ai) {
            u32x4 xv[4][2];
#pragma unroll
            for (int m = 0; m < 4; ++m)
#pragma unroll
                for (int bj = 0; bj < 2; ++bj) xv[m][bj] = *(const u32x4*)(XB + (size_t)EPI_ROW(u, ai, m) * D + EPI_COLP(u, bj));
#pragma unroll
            for (int m = 0; m < 4; ++m) {
                const int row = EPI_ROW(u, ai, m);
                float part = 0.f;
#pragma unroll
                for (int bj = 0; bj < 2; ++bj) {
                    const u32x4 q = xv[m][bj]; float* yp = Y + (size_t)row * D + EPI_COLP(u, bj);
                    const f32x4 v0 = acc[ai][bj][m][0] + (f32x4){bflo(q.x), bfhi(q.x), bflo(q.y), bfhi(q.y)}, v1 = acc[ai][bj][m][1] + (f32x4){bflo(q.z), bfhi(q.z), bflo(q.w), bfhi(q.w)};
                    *(f32x4*)yp = v0; *(f32x4*)(yp + 4) = v1;
                    part += ((v0[0] * v0[0] + v0[1] * v0[1]) + (v0[2] * v0[2] + v0[3] * v0[3])) + ((v1[0] * v1[0] + v1[1] * v1[1]) + (v1[2] * v1[2] + v1[3] * v1[3]));
                }
                part += __shfl_xor(part, 16); part += __shfl_xor(part, 32);
                if (fq == 0) atomicAdd(ss + row, part);
            }
        }
    }
};
struct EpiNull { static constexpr bool PERM = false; float* sink; int never;
    __device__ __forceinline__ void operator()(const f32x4 (&acc)[2][2][4][2], const pg8::Unit& u, int wr, int wc, int fr, int fq) const {
        if (never) {
#pragma unroll
            for (int ai = 0; ai < 2; ++ai)
#pragma unroll
                for (int m = 0; m < 4; ++m)
#pragma unroll
                    for (int bj = 0; bj < 2; ++bj)
#pragma unroll
                        for (int n = 0; n < 2; ++n) *(f32x4*)(sink + (size_t)EPI_ROW(u, ai, m) * D + EPI_COL(u, bj, n)) = acc[ai][bj][m][n];
        }
    }
};

#define XB_TMO      128
#define XB_XCNT(j)  (256  + 64 * (j))
#define XB_XSUB(j)  (1280 + 64 * (j))
#define XB_XGEN(j)  (2304 + 64 * (j))
#define XB_TOP      3328
#define XB_TOPGEN   3392
#define XCD_BAR_WORDS 3456
#define XB_SPIN_CAP (1u << 18)
__device__ __forceinline__ unsigned xb_ld(unsigned* p)              { return __hip_atomic_load(p, __ATOMIC_RELAXED, __HIP_MEMORY_SCOPE_AGENT); }
__device__ __forceinline__ unsigned xb_add(unsigned* p, unsigned v) { return __hip_atomic_fetch_add(p, v, __ATOMIC_RELAXED, __HIP_MEMORY_SCOPE_AGENT); }
__device__ __forceinline__ unsigned xb_xcc_id() { return (unsigned)__builtin_amdgcn_s_getreg((3 << 11) | 20) & 0xFu; }
#define XB_SPIN(cond, bar) do { unsigned _sp = 0; while (cond) { __builtin_amdgcn_s_sleep(1); \
    if ((++_sp & 255u) == 0u) { if (xb_ld(&(bar)[XB_TMO])) break; if (_sp > XB_SPIN_CAP) { atomicAdd(&(bar)[XB_TMO], 1u); break; } } } } while (0)
struct XcdBarrier { unsigned* bar; unsigned x; volatile LAS unsigned* st; };
__device__ __forceinline__ XcdBarrier xcd_barrier_post(unsigned* bar, volatile LAS unsigned* st) {
    XcdBarrier b; b.bar = bar; b.x = xb_xcc_id(); b.st = st;
    if (threadIdx.x == 0) (void)xb_add(&bar[XB_XCNT(b.x)], 1u);
    return b;
}
__device__ __forceinline__ void xcd_barrier_complete(unsigned* bar, unsigned x, unsigned& nloc, unsigned& nx) {
    const unsigned G = gridDim.x * gridDim.y * gridDim.z;
    unsigned sum, cnt, mine, sp = 0u;
    for (;;) {
        sum = 0u; cnt = 0u; mine = 0u;
#pragma unroll
        for (unsigned j = 0; j < 16; ++j) { const unsigned c = xb_ld(&bar[XB_XCNT(j)]); sum += c; cnt += (c > 0u) ? 1u : 0u; mine = (j == x) ? c : mine; }
        if (sum == G) break;
        __builtin_amdgcn_s_sleep(1);
        if ((++sp & 255u) == 0u) { if (xb_ld(&bar[XB_TMO])) break; if (sp > XB_SPIN_CAP) { atomicAdd(&bar[XB_TMO], 1u); break; } }
    }
    nloc = mine > 0u ? mine : 1u; nx = cnt > 0u ? cnt : 1u;
}
__device__ __forceinline__ void xcd_barrier(const XcdBarrier& b) {
    asm volatile("s_waitcnt vmcnt(0)" ::: "memory");
    __syncthreads();
    if (threadIdx.x == 0) {
        unsigned* bar = b.bar;
        __builtin_amdgcn_s_waitcnt(0);
        unsigned nloc = b.st[0], nx = b.st[1];
        if (nloc == 0u) { xcd_barrier_complete(bar, b.x, nloc, nx); b.st[0] = nloc; b.st[1] = nx; }
        const unsigned old = xb_add(&bar[XB_XSUB(b.x)], 1u);
        const unsigned gen = old / nloc;
        if (old + 1u == (gen + 1u) * nloc) {
            __builtin_amdgcn_fence(__ATOMIC_RELEASE, "agent");
            asm volatile("s_waitcnt vmcnt(0)" ::: "memory");
            const unsigned og = xb_add(&bar[XB_TOP], 1u);
            const unsigned tg = og / nx;
            if (og + 1u == (tg + 1u) * nx) xb_add(&bar[XB_TOPGEN], 1u);
            else XB_SPIN(xb_ld(&bar[XB_TOPGEN]) == tg, bar);
            __builtin_amdgcn_fence(__ATOMIC_ACQUIRE, "agent");
            xb_add(&bar[XB_XGEN(b.x)], 1u);
            asm volatile("s_waitcnt vmcnt(0)" ::: "memory");
        } else {
            XB_SPIN(xb_ld(&bar[XB_XGEN(b.x)]) == gen, bar);
            __builtin_amdgcn_fence(__ATOMIC_ACQUIRE, "agent");
            asm volatile("s_waitcnt vmcnt(0)" ::: "memory");
        }
    }
    __syncthreads();
}

struct Frame {
    unsigned char* lds; int tid, lane, wave, G, bid;
    const float* const* in; float* out; unsigned char* ws; float* misc;
};

__device__ __forceinline__ void p0_transpose_item(const float* W, int K, int N, bf16_t* WT, const float* g, float* scr, int item, int lane) {
    const int nblk = N / 32, kb = item / nblk, nb = item % nblk, k0 = 64 * kb, n0 = 32 * nb;
#pragma unroll
    for (int i = 0; i < 32; ++i) { const int kk = 2 * i + (lane >> 5); float v = W[(size_t)(k0 + kk) * N + n0 + (lane & 31)]; if (g) v *= g[k0 + kk]; scr[kk * 33 + (lane & 31)] = v; }
    LDS_WAIT();
    const int c = lane & 7;
#pragma unroll
    for (int j = 0; j < 4; ++j) { const int n = (lane >> 3) + 8 * j; const float* s = scr + (8 * c) * 33 + n;
        u32x4 o; o.x = pk2(s[0 * 33], s[1 * 33]); o.y = pk2(s[2 * 33], s[3 * 33]); o.z = pk2(s[4 * 33], s[5 * 33]); o.w = pk2(s[6 * 33], s[7 * 33]);
        *(u32x4*)(WT + (size_t)(n0 + n) * K + k0 + 8 * c) = o; }
    LDS_WAIT();
}
__device__ __forceinline__ void phase_prologue(Frame& F) {
    float* scr = (float*)(F.lds + F.wave * 16384);
    const int gw = F.bid * NWAVES + F.wave, NGW = F.G * NWAVES;
    bf16_t* W1T = (bf16_t*)(F.ws + WS_W1T); bf16_t* W2T = (bf16_t*)(F.ws + WS_W2T); bf16_t* W3T = (bf16_t*)(F.ws + WS_W3T); bf16_t* W4T = (bf16_t*)(F.ws + WS_W4T);
    constexpr int I1 = (D / 64) * (RWIN / 32), I2 = (E / 64) * (D / 32), I3 = (D / 64) * (GMIN / 32), I4 = (E / 64) * (D / 32);
    for (int it = gw; it < I1 + I2 + I3 + I4; it += NGW) {
        int r = it;
        if (r < I1) { p0_transpose_item(F.in[6], D, RWIN, W1T, F.in[4], scr, r, F.lane); continue; } r -= I1;
        if (r < I2) { p0_transpose_item(F.in[17], E, D, W2T, nullptr, scr, r, F.lane); continue; } r -= I2;
        if (r < I3) { p0_transpose_item(F.in[18], D, GMIN, W3T, F.in[4] + D, scr, r, F.lane); continue; } r -= I3;
        p0_transpose_item(F.in[23], E, D, W4T, nullptr, scr, r, F.lane);
    }
    { u32x4* z = (u32x4*)(W1T + (size_t)RWIN * D); const int n = (RWIN_PAD - RWIN) * D * 2 / 16;
      for (int i = F.bid * NTHREADS + F.tid; i < n; i += F.G * NTHREADS) z[i] = (u32x4){0u, 0u, 0u, 0u};
      float* zs = F.misc + MI_SS1; for (int i = F.bid * NTHREADS + F.tid; i < 4 * MTOT; i += F.G * NTHREADS) zs[i] = 0.f; }
    bf16_t* XB = (bf16_t*)(F.out + OFF_SWKV);
    for (int gr = gw; gr < MTOT; gr += NGW) {
        const float* xr = gr < MP ? F.in[0] + (size_t)gr * D : F.in[1] + (size_t)(gr - MP) * D;
        int pmi;
        if (gr < MP) { const int b = gr >> 11, t = gr & 2047; pmi = t < 1024 ? b * 1024 + t : PA_ROWS + b * 1024 + (t - 1024); } else pmi = gr;
        const f32x4* x4 = (const f32x4*)xr + F.lane;
        f32x4 v[4]; float s = 0.f;
#pragma unroll
        for (int j = 0; j < 4; ++j) { v[j] = x4[64 * j]; s += (v[j][0] * v[j][0] + v[j][1] * v[j][1]) + (v[j][2] * v[j][2] + v[j][3] * v[j][3]); }
        s = wave_sum(s);
        u32x2* o = (u32x2*)(XB + (size_t)pmi * D) + F.lane;
#pragma unroll
        for (int j = 0; j < 4; ++j) { u32x2 w; w.x = pk2(v[j][0], v[j][1]); w.y = pk2(v[j][2], v[j][3]); o[64 * j] = w; }
        if (F.lane == 0) F.misc[MI_RS0 + pmi] = rsqrtf(s * (1.f / D) + 1e-6f);
    }
}

constexpr int TT = 32;
#define WKV_STEP(S, pW, pA, pB, pK, pR, vval, yout) do { \
    float sa0 = 0.f, sa1 = 0.f; \
    _Pragma("unroll") for (int k4 = 0; k4 < 16; ++k4) { const f32x4 a = ((const f32x4*)(pA))[k4]; sa0 += S[4 * k4] * a[0] + S[4 * k4 + 2] * a[2]; sa1 += S[4 * k4 + 1] * a[1] + S[4 * k4 + 3] * a[3]; } \
    const float sa = sa0 + sa1; float y0 = 0.f, y1 = 0.f; \
    _Pragma("unroll") for (int k4 = 0; k4 < 16; ++k4) { const f32x4 w = ((const f32x4*)(pW))[k4], bb = ((const f32x4*)(pB))[k4], kk = ((const f32x4*)(pK))[k4], rr = ((const f32x4*)(pR))[k4]; \
        _Pragma("unroll") for (int e = 0; e < 4; ++e) { float s = S[4 * k4 + e] * w[e] + sa * bb[e] + (vval) * kk[e]; S[4 * k4 + e] = s; if (e & 1) y1 += s * rr[e]; else y0 += s * rr[e]; } } \
    (yout) = y0 + y1; } while (0)

__device__ __forceinline__ void load_tok(const bf16_t* P, const float* carry, int pass, int b, int hc, int c, int t, unsigned (&x)[6]) {
    const bf16_t* pr = P + (size_t)(b * 1024 + t) * RWIN;
    unsigned s0 = pr[hc + c], s1 = pr[E + hc + c], s2 = pr[2 * E + hc + c], s3 = pr[3 * E + c], s4 = pr[3 * E + 64 + c];
    x[5] = pr[SHIFTC + hc + c];
    unsigned q0 = 0, q1 = 0, q2 = 0, q3 = 0, q4 = 0;
    if (t > 0) { const bf16_t* pp = pr - RWIN; q0 = pp[hc + c]; q1 = pp[E + hc + c]; q2 = pp[2 * E + hc + c]; q3 = pp[3 * E + c]; q4 = pp[3 * E + 64 + c]; }
    else if (pass != 0) { const float* cr = carry + (size_t)b * SHIFTC;
        q0 = pk2(cr[hc + c], 0.f) & 0xffffu; q1 = pk2(cr[E + hc + c], 0.f) & 0xffffu; q2 = pk2(cr[2 * E + hc + c], 0.f) & 0xffffu; q3 = pk2(cr[3 * E + c], 0.f) & 0xffffu; q4 = pk2(cr[3 * E + 64 + c], 0.f) & 0xffffu; }
    x[0] = s0 | (q0 << 16); x[1] = s1 | (q1 << 16); x[2] = s2 | (q2 << 16); x[3] = s3 | (q3 << 16); x[4] = s4 | (q4 << 16);
}
__device__ __forceinline__ void scan_prompt(Frame& F, int pass) {
    unsigned char* Lb = F.lds;
    bf16_t* W2Tb = (bf16_t*)Lb; bf16_t* A2Tb = (bf16_t*)(Lb + 9216);
    float* PAR = (float*)(Lb + 18432);
    bf16_t* SHI = (bf16_t*)(Lb + 22528); bf16_t* SLO = (bf16_t*)(Lb + 31744);
    bf16_t* TWb = (bf16_t*)(Lb + 40960); bf16_t* TAb = (bf16_t*)(Lb + 45568);
    bf16_t* AHb = TWb; bf16_t* RHb = TAb;
    float* VW = (float*)(Lb + 50176); float* VA = VW + 2048; float* VB = VA + 2048; float* VK = VB + 2048; float* VR = VK + 2048; float* VV = VR + 2048; float* VY = VV + 2048;
    float* UT = VW; float* YT = VB;
    bf16_t* ATb = (bf16_t*)(Lb + 107520); bf16_t* BTb = ATb + 2304; bf16_t* KTb = BTb + 2304; bf16_t* RTb = KTb + 2304;
    bf16_t* BKpT = (bf16_t*)(Lb + 125952);
    bf16_t* UVT = (bf16_t*)(Lb + 136192);
    float* GR = (float*)(Lb + 146432);
    float* PC = (float*)(Lb + 154624);
    float* BON = (float*)(Lb + 155136);
    bf16_t* GLb = (bf16_t*)(Lb + 155264);
    const bf16_t* P = (const bf16_t*)(F.ws + WS_PROJH);
    bf16_t* O = (bf16_t*)(F.ws + WS_O);
    const float* carry = F.misc + MI_CARRY;
    float* pwkv = F.out + OFF_PWKV;
    const int lane = F.lane, tid = F.tid, wave = F.wave, fr = lane & 15, fq = lane >> 4;
    for (int u = F.bid; u < 256; u += F.G) {
        const int b = u >> 5, h = u & 31, hc = h * 64;
        __syncthreads();
        for (int idx = tid; idx < 4096; idx += NTHREADS) { const int j = idx >> 6, c = idx & 63;
            W2Tb[c * 72 + j] = (bf16_t)(pk2(F.in[9][(size_t)j * E + hc + c], 0.f) & 0xffffu); A2Tb[c * 72 + j] = (bf16_t)(pk2(F.in[11][(size_t)j * E + hc + c], 0.f) & 0xffffu); }
        for (int idx = tid; idx < 2 * 64 * 8; idx += NTHREADS) { const int r = idx >> 3, q = idx & 7; *(unsigned*)(UVT + r * 40 + 2 * q) = 0u; }
        if (tid < 64) { const int c = tid;
            PAR[0 * 64 + c] = F.in[7][hc + c]; PAR[1 * 64 + c] = F.in[7][E + hc + c]; PAR[2 * 64 + c] = F.in[7][2 * E + hc + c]; PAR[3 * 64 + c] = F.in[7][3 * E + c]; PAR[4 * 64 + c] = F.in[7][3 * E + 64 + c];
            PAR[5 * 64 + c] = F.in[8][hc + c]; PAR[6 * 64 + c] = F.in[10][hc + c]; PAR[7 * 64 + c] = F.in[12][hc + c]; PAR[8 * 64 + c] = F.in[13][hc + c]; PAR[9 * 64 + c] = F.in[14][hc + c];
            PAR[10 * 64 + c] = F.in[15][hc + c]; PAR[11 * 64 + c] = F.in[16][hc + c]; }
        const int vt = wave & 3, kt0 = 2 * (wave >> 2);
        f32x4 accS[2];
        float* sgp = pwkv + ((size_t)(b * NH + h) * 64 + 16 * vt + fr) * 64 + 16 * kt0 + 4 * fq;
        if (pass == 0) { accS[0] = (f32x4){0.f, 0.f, 0.f, 0.f}; accS[1] = accS[0]; }
        else { accS[0] = *(const f32x4*)sgp; accS[1] = *(const f32x4*)(sgp + 16); }
#pragma unroll
        for (int q = 0; q < 2; ++q) {
            const unsigned h01 = pk2(accS[q][0], accS[q][1]), h23 = pk2(accS[q][2], accS[q][3]);
            const unsigned l01 = pk2(accS[q][0] - bflo(h01), accS[q][1] - bfhi(h01)), l23 = pk2(accS[q][2] - bflo(h23), accS[q][3] - bfhi(h23));
            u32x2 hv; hv.x = h01; hv.y = h23; u32x2 lv; lv.x = l01; lv.y = l23;
            *(u32x2*)(SHI + (16 * vt + fr) * 72 + 16 * (kt0 + q) + 4 * fq) = hv; *(u32x2*)(SLO + (16 * vt + fr) * 72 + 16 * (kt0 + q) + 4 * fq) = lv;
        }
        unsigned X[4][6];
#pragma unroll
        for (int i = 0; i < 4; ++i) load_tok(P, carry, pass, b, hc, lane, wave + NWAVES * i, X[i]);
        __syncthreads();
#pragma unroll 1
        for (int c0 = 0; c0 < 1024; c0 += TT) {
            float zc[4];
#pragma unroll
            for (int i = 0; i < 4; ++i) {
                const int tl = wave + NWAVES * i, c = lane;
                const float rv = bflo(X[i][0]) + (bfhi(X[i][0]) - bflo(X[i][0])) * PAR[c], kv = bflo(X[i][1]) + (bfhi(X[i][1]) - bflo(X[i][1])) * PAR[64 + c], vv = bflo(X[i][2]) + (bfhi(X[i][2]) - bflo(X[i][2])) * PAR[128 + c];
                const float wd = bflo(X[i][3]) + (bfhi(X[i][3]) - bflo(X[i][3])) * PAR[192 + c], ad = bflo(X[i][4]) + (bfhi(X[i][4]) - bflo(X[i][4])) * PAR[256 + c];
                zc[i] = bflo(X[i][5]);
                VR[tl * 64 + c] = rv; VK[tl * 64 + c] = kv; VV[tl * 64 + c] = vv;
                UVT[(tl >> 4) * 2560 + c * 40 + 16 + (tl & 15)] = (bf16_t)(pk2(vv, 0.f) & 0xffffu);
                TWb[tl * 72 + c] = (bf16_t)(pk2(tanh_(wd), 0.f) & 0xffffu); TAb[tl * 72 + c] = (bf16_t)(pk2(ad, 0.f) & 0xffffu);
                float kk = kv * PAR[7 * 64 + c];
                const float nrm = wave_sum(kk * kk);
                VA[tl * 64 + c] = -(kk * rsqrtf(fmaxf(nrm, 1e-24f)));
            }
            LBAR();
            if (c0 + TT < 1024) {
#pragma unroll
                for (int i = 0; i < 4; ++i) load_tok(P, carry, pass, b, hc, lane, c0 + TT + wave + NWAVES * i, X[i]);
            }
            { const int tt = wave & 1, ct = wave >> 1;
              f32x4 aw = (f32x4){0.f, 0.f, 0.f, 0.f}, aa = (f32x4){0.f, 0.f, 0.f, 0.f};
#pragma unroll
              for (int k2 = 0; k2 < 2; ++k2) {
                  const bf16x8 xw = *(const bf16x8*)(W2Tb + (ct * 16 + fr) * 72 + k2 * 32 + fq * 8), yw = *(const bf16x8*)(TWb + (tt * 16 + fr) * 72 + k2 * 32 + fq * 8);
                  const bf16x8 xa = *(const bf16x8*)(A2Tb + (ct * 16 + fr) * 72 + k2 * 32 + fq * 8), ya = *(const bf16x8*)(TAb + (tt * 16 + fr) * 72 + k2 * 32 + fq * 8);
                  aw = __builtin_amdgcn_mfma_f32_16x16x32_bf16(xw, yw, aw, 0, 0, 0); aa = __builtin_amdgcn_mfma_f32_16x16x32_bf16(xa, ya, aa, 0, 0, 0);
              }
              const int tl = tt * 16 + fr, c4 = ct * 16 + 4 * fq;
              *(f32x4*)(VW + tl * 64 + c4) = aw; *(f32x4*)(VB + tl * 64 + c4) = aa; }
            LBAR();
#pragma unroll
            for (int i = 0; i < 4; ++i) {
                const int tl = wave + NWAVES * i, c = lane;
                const float wf = PAR[5 * 64 + c] + VW[tl * 64 + c], af = PAR[6 * 64 + c] + VB[tl * 64 + c];
                const float dec = __expf(-0.6065306597126334f * sigmoidf_(wf));
                const float av = sigmoidf_(af);
                const float kraw = VK[tl * 64 + c], rv = VR[tl * 64 + c], kkn = -VA[tl * 64 + c];
                const float kp = kraw * (1.f + (av - 1.f) * PAR[8 * 64 + c]);
                const float bon = wave_sum(rv * kp * PAR[9 * 64 + c]);
                VW[tl * 64 + c] = dec; VB[tl * 64 + c] = kkn * av; VK[tl * 64 + c] = kp;
                if (c == 0) BON[tl] = bon;
            }
            LBAR();
            if (wave < 2) {
                const int ch = wave, r0 = ch * 16, k = lane;
                float p = 1.f;
#pragma unroll 4
                for (int i = 0; i < 16; ++i) {
                    const int o = (r0 + i) * 64 + k;
                    const float w = VW[o], av = VA[o], bv = VB[o], kv = VK[o], rv = VR[o];
                    const float at = av * p; p *= w; const float ip = rcp_(p);
                    const float bt = bv * ip, kt = kv * ip, rt = rv * p;
                    ATb[ch * 1152 + i * 72 + k] = (bf16_t)(pk2(at, 0.f) & 0xffffu); BTb[ch * 1152 + i * 72 + k] = (bf16_t)(pk2(bt, 0.f) & 0xffffu);
                    KTb[ch * 1152 + i * 72 + k] = (bf16_t)(pk2(kt, 0.f) & 0xffffu); RTb[ch * 1152 + i * 72 + k] = (bf16_t)(pk2(rt, 0.f) & 0xffffu);
                    VA[o] = at; VR[o] = rt; VB[o] = bt; VK[o] = kt;
                }
                PC[ch * 64 + k] = p;
#pragma unroll 4
                for (int i = 0; i < 16; i += 2) {
                    const int o = (r0 + i) * 64 + k;
                    *(unsigned*)(BKpT + ch * 2560 + k * 40 + i) = pk2(VB[o] * p, VB[o + 64] * p);
                    *(unsigned*)(BKpT + ch * 2560 + k * 40 + 16 + i) = pk2(VK[o] * p, VK[o + 64] * p);
                }
            }
            LBAR();
            { const int ch = wave >> 2, which = wave & 3;
              const bf16_t* Xp = ((which < 2) ? ATb : RTb) + ch * 1152; const bf16_t* Yp = ((which & 1) ? KTb : BTb) + ch * 1152;
              f32x4 g = (f32x4){0.f, 0.f, 0.f, 0.f};
#pragma unroll
              for (int k2 = 0; k2 < 2; ++k2) { const bf16x8 xf = *(const bf16x8*)(Xp + fr * 72 + k2 * 32 + fq * 8), yf = *(const bf16x8*)(Yp + fr * 72 + k2 * 32 + fq * 8);
                  g = __builtin_amdgcn_mfma_f32_16x16x32_bf16(xf, yf, g, 0, 0, 0); }
              float* gp = GR + (ch * 4 + which) * 256;
#pragma unroll
              for (int jj = 0; jj < 4; ++jj) { const int i = 4 * fq + jj, j = fr; const bool keep = (which < 2) ? (j < i) : (j <= i); const float gv = keep ? g[jj] : 0.f; gp[i * 16 + j] = gv;
                  if (which & 1) { bf16_t* gl = GLb + (ch * 2 + (which >> 1)) * 640 + i * 40; gl[j] = 0; gl[16 + j] = (bf16_t)(pk2(gv, 0.f) & 0xffffu); } } }
            LBAR();
            { const int ch = wave >> 2, vt2 = wave & 3;
              const bf16x8 yf = *(const bf16x8*)(UVT + ch * 2560 + (16 * vt2 + fr) * 40 + fq * 8);
              const bf16x8 x1 = *(const bf16x8*)(GLb + (ch * 2 + 0) * 640 + fr * 40 + fq * 8), x2 = *(const bf16x8*)(GLb + (ch * 2 + 1) * 640 + fr * 40 + fq * 8);
              const f32x4 z4 = (f32x4){0.f, 0.f, 0.f, 0.f};
              const f32x4 t1 = __builtin_amdgcn_mfma_f32_16x16x32_bf16(x1, yf, z4, 0, 0, 0), t2 = __builtin_amdgcn_mfma_f32_16x16x32_bf16(x2, yf, z4, 0, 0, 0);
              *(f32x4*)(UT + ch * 1024 + (16 * vt2 + fr) * 16 + 4 * fq) = t1; *(f32x4*)(YT + ch * 1024 + (16 * vt2 + fr) * 16 + 4 * fq) = t2; }
            LBAR();
#define TRI_ROW(G4, i, NJ, a0, a1) do { _Pragma("unroll") for (int j4 = 0; j4 < ((NJ) + 3) / 4; ++j4) { const f32x4 g = (G4)[(i) * 4 + j4]; \
        _Pragma("unroll") for (int e = 0; e < 4; ++e) { const int j = 4 * j4 + e; if (j < (NJ)) { if (j & 1) a1 += g[e] * x[j]; else a0 += g[e] * x[j]; } } } } while (0)
            if (wave < 4) {
                const int ch = wave >> 1, r0 = ch * 16, col = lane;
                const f32x4* Lab4 = (const f32x4*)(GR + (ch * 4 + 0) * 256); const f32x4* Mrb4 = (const f32x4*)(GR + (ch * 4 + 2) * 256);
                float x[16];
                if ((wave & 1) == 0) {
#pragma unroll
                    for (int i = 0; i < 16; ++i) { float a0 = VA[(r0 + i) * 64 + col], a1 = 0.f; TRI_ROW(Lab4, i, i, a0, a1);
                        x[i] = a0 + a1; AHb[ch * 1152 + i * 72 + col] = (bf16_t)(pk2(x[i], 0.f) & 0xffffu); asm volatile("" ::: "memory"); }
#pragma unroll
                    for (int i = 0; i < 16; ++i) { float a0 = VR[(r0 + i) * 64 + col], a1 = 0.f; TRI_ROW(Mrb4, i, i + 1, a0, a1);
                        RHb[ch * 1152 + i * 72 + col] = (bf16_t)(pk2(a0 + a1, 0.f) & 0xffffu); asm volatile("" ::: "memory"); }
                } else {
                    float* ut = UT + ch * 1024 + col * 16; float* yt = YT + ch * 1024 + col * 16;
#pragma unroll
                    for (int i = 0; i < 16; ++i) { float a0 = ut[i], a1 = 0.f; TRI_ROW(Lab4, i, i, a0, a1);
                        x[i] = a0 + a1; ut[i] = x[i]; asm volatile("" ::: "memory"); }
#pragma unroll
                    for (int i = 0; i < 16; ++i) { float a0 = yt[i], a1 = 0.f; TRI_ROW(Mrb4, i, i + 1, a0, a1);
                        yt[i] = a0 + a1; asm volatile("" ::: "memory"); }
                }
            }
            LBAR();
#pragma unroll 1
            for (int ch = 0; ch < 2; ++ch) {
                { const int vt2 = wave & 3; const bf16_t* Xp = ((wave < 4) ? AHb : RHb) + ch * 1152;
                  f32x4 d = (f32x4){0.f, 0.f, 0.f, 0.f};
#pragma unroll
                  for (int k2 = 0; k2 < 2; ++k2) { const bf16x8 xf = *(const bf16x8*)(Xp + fr * 72 + k2 * 32 + fq * 8);
                      const bf16x8 yh = *(const bf16x8*)(SHI + (16 * vt2 + fr) * 72 + k2 * 32 + fq * 8), yl = *(const bf16x8*)(SLO + (16 * vt2 + fr) * 72 + k2 * 32 + fq * 8);
                      d = __builtin_amdgcn_mfma_f32_16x16x32_bf16(xf, yh, d, 0, 0, 0); d = __builtin_amdgcn_mfma_f32_16x16x32_bf16(xf, yl, d, 0, 0, 0); }
                  if (wave < 4) { const f32x4 uu = d + *(const f32x4*)(UT + ch * 1024 + (16 * vt2 + fr) * 16 + 4 * fq);
                      u32x2 o; o.x = pk2(uu[0], uu[1]); o.y = pk2(uu[2], uu[3]); *(u32x2*)(UVT + ch * 2560 + (16 * vt2 + fr) * 40 + 4 * fq) = o; }
                  else { const f32x4 yy = d + *(const f32x4*)(YT + ch * 1024 + (16 * vt2 + fr) * 16 + 4 * fq);
#pragma unroll
                      for (int jj = 0; jj < 4; ++jj) VY[(ch * 16 + 4 * fq + jj) * 64 + 16 * vt2 + fr] = yy[jj]; } }
                LBAR();
#pragma unroll
                for (int q = 0; q < 2; ++q) { const int kt = kt0 + q;
                    const f32x4 pc = *(const f32x4*)(PC + ch * 64 + 16 * kt + 4 * fq);
                    const bf16x8 xf = *(const bf16x8*)(BKpT + ch * 2560 + (16 * kt + fr) * 40 + fq * 8), yf = *(const bf16x8*)(UVT + ch * 2560 + (16 * vt + fr) * 40 + fq * 8);
                    accS[q] = __builtin_amdgcn_mfma_f32_16x16x32_bf16(xf, yf, accS[q] * pc, 0, 0, 0);
                    const unsigned h01 = pk2(accS[q][0], accS[q][1]), h23 = pk2(accS[q][2], accS[q][3]);
                    const unsigned l01 = pk2(accS[q][0] - bflo(h01), accS[q][1] - bfhi(h01)), l23 = pk2(accS[q][2] - bflo(h23), accS[q][3] - bfhi(h23));
                    u32x2 hv; hv.x = h01; hv.y = h23; u32x2 lv; lv.x = l01; lv.y = l23;
                    *(u32x2*)(SHI + (16 * vt + fr) * 72 + 16 * kt + 4 * fq) = hv; *(u32x2*)(SLO + (16 * vt + fr) * 72 + 16 * kt + 4 * fq) = lv; }
                LBAR();
            }
#pragma unroll
            for (int i = 0; i < 4; ++i) {
                const int tl = wave + NWAVES * i, c = lane;
                const float y = VY[tl * 64 + c];
                const float mean = wave_sum(y) * (1.f / 64.f); const float dy = y - mean;
                const float var = wave_sum(dy * dy) * (1.f / 64.f);
                const float yn = dy * rsqrtf(var + 64e-5f) * PAR[10 * 64 + c] + PAR[11 * 64 + c];
                const float z = zc[i];
                const float o = (yn + BON[tl] * VV[tl * 64 + c]) * (z * sigmoidf_(z));
                const int grow = b * 2048 + pass * 1024 + c0 + tl;
                const float o2 = __int_as_float(__builtin_amdgcn_update_dpp(0, __float_as_int(o), 0xF5, 0xf, 0xf, true));
                if (!(c & 1)) *(unsigned*)(O + (size_t)grow * E + hc + c) = pk2(o, o2);
            }
            LBAR();
        }
        { *(f32x4*)sgp = accS[0]; *(f32x4*)(sgp + 16) = accS[1]; }
    }
    __syncthreads();
}

__device__ __forceinline__ void scan_samples(Frame& F) {
    float* scr = (float*)F.lds + F.wave * 2560;
    float* TW = scr; float* TA = scr + 256; float* VW = scr + 512; float* VA = scr + 768; float* VB = scr + 1024; float* VK = scr + 1280; float* VR = scr + 1536; float* VV = scr + 1792; float* VY = scr + 2048; float* BON = scr + 2304;
    const bf16_t* P = (const bf16_t*)(F.ws + WS_PROJH);
    bf16_t* O = (bf16_t*)(F.ws + WS_O);
    const int c = F.lane;
    const int gw = F.bid * NWAVES + F.wave, NGW = F.G * NWAVES;
    for (int su = gw; su < 128 * NH; su += NGW) {
        const int sb = su >> 5, h = su & 31, hc = h * 64;
        const float mur = F.in[7][hc + c], muk = F.in[7][E + hc + c], muv = F.in[7][2 * E + hc + c], muwd = F.in[7][3 * E + c], muad = F.in[7][3 * E + 64 + c];
        const float* st = F.in[2] + (size_t)sb * SHIFTC;
        float qr = st[hc + c], qk = st[E + hc + c], qv = st[2 * E + hc + c], qwd = st[3 * E + c], qad = st[3 * E + 64 + c];
        float r[4], k[4], v[4];
        LDS_WAIT();
#pragma unroll
        for (int tl = 0; tl < 4; ++tl) {
            const bf16_t* pr = P + (size_t)(PA_ROWS + sb * 4 + tl) * RWIN;
            const float sr = bf2f(pr[hc + c]), sk = bf2f(pr[E + hc + c]), sv = bf2f(pr[2 * E + hc + c]), swd = bf2f(pr[3 * E + c]), sad = bf2f(pr[3 * E + 64 + c]);
            r[tl] = sr + (qr - sr) * mur; k[tl] = sk + (qk - sk) * muk; v[tl] = sv + (qv - sv) * muv;
            TW[tl * 64 + c] = tanhf(swd + (qwd - swd) * muwd); TA[tl * 64 + c] = sad + (qad - sad) * muad;
            qr = sr; qk = sk; qv = sv; qwd = swd; qad = sad;
        }
        LDS_WAIT();
        float wf[4], af[4];
        { const float w0 = F.in[8][hc + c], a0 = F.in[10][hc + c];
#pragma unroll
          for (int tl = 0; tl < 4; ++tl) { wf[tl] = w0; af[tl] = a0; } }
#pragma unroll 16
        for (int j = 0; j < 64; ++j) {
            const float w2 = F.in[9][(size_t)j * E + hc + c], a2 = F.in[11][(size_t)j * E + hc + c];
#pragma unroll
            for (int tl = 0; tl < 4; ++tl) { wf[tl] += TW[tl * 64 + j] * w2; af[tl] += TA[tl * 64 + j] * a2; }
        }
        const float kkp = F.in[12][hc + c], kap = F.in[13][hc + c], rkp = F.in[14][hc + c];
#pragma unroll
        for (int tl = 0; tl < 4; ++tl) {
            const float dec = __expf(-0.6065306597126334f * sigmoidf_(wf[tl]));
            const float av = sigmoidf_(af[tl]);
            float kk = k[tl] * kkp;
            const float nrm = wave_sum(kk * kk);
            kk = kk / fmaxf(sqrtf(nrm), 1e-12f);
            const float kp = k[tl] * (1.f + (av - 1.f) * kap);
            const float bon = wave_sum(r[tl] * kp * rkp);
            VW[tl * 64 + c] = dec; VA[tl * 64 + c] = -kk; VB[tl * 64 + c] = kk * av; VK[tl * 64 + c] = kp; VR[tl * 64 + c] = r[tl]; VV[tl * 64 + c] = v[tl];
            if (c == 0) BON[tl] = bon;
        }
        LDS_WAIT();
        float S[64];
        { const f32x4* sp = (const f32x4*)(F.in[3] + ((size_t)(sb * NH + h) * 64 + c) * 64);
#pragma unroll
          for (int k4 = 0; k4 < 16; ++k4) { const f32x4 t = sp[k4]; S[4 * k4] = t[0]; S[4 * k4 + 1] = t[1]; S[4 * k4 + 2] = t[2]; S[4 * k4 + 3] = t[3]; } }
#pragma unroll 1
        for (int tl = 0; tl < 4; ++tl) { const float vv = VV[tl * 64 + c]; float y; WKV_STEP(S, VW + tl * 64, VA + tl * 64, VB + tl * 64, VK + tl * 64, VR + tl * 64, vv, y); VY[tl * 64 + c] = y; }
        { f32x4* sp = (f32x4*)(F.out + OFF_SWKV + ((size_t)(sb * NH + h) * 64 + c) * 64);
#pragma unroll
          for (int k4 = 0; k4 < 16; ++k4) sp[k4] = (f32x4){S[4 * k4], S[4 * k4 + 1], S[4 * k4 + 2], S[4 * k4 + 3]}; }
        const float lng = F.in[15][hc + c], lnb = F.in[16][hc + c];
        LDS_WAIT();
#pragma unroll 1
        for (int tl = 0; tl < 4; ++tl) {
            const float yv = VY[tl * 64 + c];
            const float mean = wave_sum(yv) * (1.f / 64.f); const float dy = yv - mean;
            const float var = wave_sum(dy * dy) * (1.f / 64.f);
            const float yn = dy * rsqrtf(var + 64e-5f) * lng + lnb;
            const float z = bf2f(P[(size_t)(PA_ROWS + sb * 4 + tl) * RWIN + SHIFTC + hc + c]);
            const float o = (yn + BON[tl] * VV[tl * 64 + c]) * (z * sigmoidf_(z));
            const float o2 = __shfl_down(o, 1);
            if (!(c & 1)) *(unsigned*)(O + (size_t)(MP + sb * 4 + tl) * E + hc + c) = pk2(o, o2);
        }
    }
}

constexpr int GP = 136;
__device__ __forceinline__ void phase_gate(Frame& F) {
    bf16_t* P2 = (bf16_t*)(F.ws + WS_PROJ2);
    const float* vsum = F.misc + MI_VSUM; const float* vsq = F.misc + MI_VSQ;
    bf16_t* WM = (bf16_t*)F.lds; bf16_t* VT = WM + 128 * GP;
    const int tid = F.tid, lane = F.lane, fr = lane & 15, fq = lane >> 4;
    const bool wm_once = (F.G & 7) == 0;
    for (int u = F.bid, first = 1; u < 1024; u += F.G, first = 0) {
        const int bc = u >> 3, g = u & 7, row0 = bc * 128;
        __syncthreads();
        if (first || !wm_once)
        for (int idx = tid; idx < 128 * 32; idx += NTHREADS) { const int t = idx >> 5, s4 = (idx & 31) * 4;
            const f32x4 w = *(const f32x4*)(F.in[21] + ((size_t)g * 128 + t) * 128 + s4);
            u32x2 o; o.x = pk2(s4 <= t ? w[0] : 0.f, s4 + 1 <= t ? w[1] : 0.f); o.y = pk2(s4 + 2 <= t ? w[2] : 0.f, s4 + 3 <= t ? w[3] : 0.f);
            *(u32x2*)(WM + t * GP + s4) = o; }
        for (int idx = tid; idx < 128 * 32; idx += NTHREADS) { const int s = (idx & 15) + 16 * (idx >> 9), d8 = ((idx >> 4) & 31) * 8, row = row0 + s;
            const float mean = vsum[row] * (1.f / E); const float rstd = rsqrtf(vsq[row] * (1.f / E) - mean * mean + 1e-5f);
            const u32x4 raw = *(const u32x4*)(P2 + (size_t)row * GMIN + E + g * 256 + d8);
            const float* vg = F.in[19] + g * 256 + d8; const float* vb = F.in[20] + g * 256 + d8;
            float x[8] = {bflo(raw.x), bfhi(raw.x), bflo(raw.y), bfhi(raw.y), bflo(raw.z), bfhi(raw.z), bflo(raw.w), bfhi(raw.w)};
#pragma unroll
            for (int e = 0; e < 8; ++e) { const float vn = (x[e] - mean) * rstd * vg[e] + vb[e]; VT[(d8 + e) * GP + s] = (bf16_t)(pk2(vn, 0.f) & 0xffffu); } }
        __syncthreads();
        const int t0 = F.wave * 16;
        f32x4 acc[16];
#pragma unroll
        for (int i = 0; i < 16; ++i) acc[i] = (f32x4){0.f, 0.f, 0.f, 0.f};
        const int nkb = (t0 + 15) / 32 + 1;
        for (int kb = 0; kb < nkb; ++kb) {
            const bf16x8 yf = *(const bf16x8*)(WM + (t0 + fr) * GP + kb * 32 + fq * 8);
#pragma unroll
            for (int dt = 0; dt < 16; ++dt) { const bf16x8 xf = *(const bf16x8*)(VT + (dt * 16 + fr) * GP + kb * 32 + fq * 8);
                acc[dt] = __builtin_amdgcn_mfma_f32_16x16x32_bf16(xf, yf, acc[dt], 0, 0, 0); }
        }
        const int t = t0 + fr, row = row0 + t; const float bias = F.in[22][g * 128 + t];
        bf16_t* prow = P2 + (size_t)row * GMIN + g * 256;
        u32x2 uu_[16], zz_[16];
#pragma unroll
        for (int dt = 0; dt < 16; ++dt) { const int d = dt * 16 + 4 * fq; uu_[dt] = *(const u32x2*)(prow + d); zz_[dt] = *(const u32x2*)(prow + 2 * E + d); }
#pragma unroll
        for (int dt = 0; dt < 16; ++dt) { const int d = dt * 16 + 4 * fq;
            const u32x2 uu = uu_[dt]; const u32x2 zz = zz_[dt];
            const float o0 = bflo(uu.x) * (acc[dt][0] + bias) * bflo(zz.x), o1 = bfhi(uu.x) * (acc[dt][1] + bias) * bfhi(zz.x);
            const float o2 = bflo(uu.y) * (acc[dt][2] + bias) * bflo(zz.y), o3 = bfhi(uu.y) * (acc[dt][3] + bias) * bfhi(zz.y);
            u32x2 o; o.x = pk2(o0, o1); o.y = pk2(o2, o3); *(u32x2*)(prow + d) = o; }
    }
    float* sv = F.out + OFF_SV;
    for (int it = F.bid * NTHREADS + tid; it < 128 * E; it += F.G * NTHREADS) {
        const int sb = it >> 11, col = it & 2047, g = col >> 8;
        const float vg = F.in[19][col], vb = F.in[20][col];
        float vn[4];
#pragma unroll
        for (int t = 0; t < 4; ++t) { const int row = MP + sb * 4 + t; const float mean = vsum[row] * (1.f / E); const float rstd = rsqrtf(vsq[row] * (1.f / E) - mean * mean + 1e-5f);
            vn[t] = (bf2f(P2[(size_t)row * GMIN + E + col]) - mean) * rstd * vg + vb; sv[((size_t)sb * 4 + t) * E + col] = vn[t]; }
#pragma unroll
        for (int t = 0; t < 4; ++t) { const int row = MP + sb * 4 + t; float mx = F.in[22][g * 128 + t];
#pragma unroll
            for (int s = 0; s <= t; ++s) mx += F.in[21][((size_t)g * 128 + t) * 128 + s] * vn[s];
            bf16_t* pu = P2 + (size_t)row * GMIN + col; const float o = bf2f(pu[0]) * mx * bf2f(pu[2 * E]);
            pu[0] = (bf16_t)(pk2(o, 0.f) & 0xffffu); }
    }
}

__device__ __forceinline__ void phase_final(Frame& F) {
    const float* ss2 = F.misc + MI_SS2; const float* gf = F.in[5];
    const int gw = F.bid * NWAVES + F.wave, NGW = F.G * NWAVES;
    f32x4 gv[4];
#pragma unroll
    for (int j = 0; j < 4; ++j) gv[j] = ((const f32x4*)gf)[F.lane + 64 * j];
    for (int row = gw; row < MTOT; row += NGW) {
        const float s = rsqrtf(ss2[row] * (1.f / D) + 1e-6f);
        f32x4* y = (f32x4*)(F.out + OFF_Y + (size_t)row * D) + F.lane;
#pragma unroll
        for (int j = 0; j < 4; ++j) { f32x4 v = y[64 * j]; v = v * s * gv[j]; y[64 * j] = v; }
    }
}

__global__ void __launch_bounds__(NTHREADS, 2) fwd_kernel(Params p) {
    extern __shared__ __attribute__((aligned(16))) unsigned char lds[];
    Frame F;
    F.lds = lds; F.tid = threadIdx.x; F.lane = F.tid & 63; F.wave = __builtin_amdgcn_readfirstlane(F.tid >> 6); F.G = gridDim.x; F.bid = blockIdx.x;
    F.in = p.in; F.out = p.out; F.ws = p.ws; F.misc = (float*)(p.ws + WS_MISC);
    const int lo = p.ph_lo, hi = p.ph_hi;
    if (lo < -1) { __threadfence(); cg::this_grid().sync(); }
#ifndef PHASE_MASK
#define PHASE_MASK 0x3ff
#endif
#define IN(k) (((PHASE_MASK >> (k)) & 1) && lo <= (k) && (k) < hi)
    volatile LAS unsigned* xst = (volatile LAS unsigned*)((LAS unsigned char*)lds + (LDS_BYTES - 16));
    if (F.tid == 0) { xst[0] = 0u; xst[1] = 0u; }
    __syncthreads();
    XcdBarrier gbar = xcd_barrier_post((unsigned*)(p.ws + WS_BAR), xst);
#define SEAM(k) do { if (IN(k) && IN((k) + 1)) { xcd_barrier(gbar); } } while (0)
    bf16_t* XB = (bf16_t*)(F.out + OFF_SWKV);
    bf16_t* PROJH = (bf16_t*)(F.ws + WS_PROJH);
#ifdef PROBE_LO
    unsigned long long* tsb = (unsigned long long*)(p.ws + WS_BAR + 32768);
#define TS(k) do { if (F.bid == 0 && F.tid == 0) tsb[k] = __builtin_amdgcn_s_memrealtime(); } while (0)
#else
#define TS(k) do {} while (0)
#endif
    TS(0);
    if (IN(0)) { phase_prologue(F); }
    SEAM(0); TS(1);
    if (IN(1)) {
        pg8::Gemm g{XB, (const bf16_t*)(F.ws + WS_W1T), PA_ROWS, RWIN_PAD, D, D}; pg8::StaticOrder S; S.init(PA_ROWS, RWIN_PAD, F.G, F.bid);
        Epi1 E1{PROJH, F.misc + MI_RS0, 0, F.out + OFF_PSHIFT, F.out + OFF_SSHIFT, F.misc + MI_CARRY};
        pg8::gemm_phase<Epi1>((LAS unsigned char*)lds, g, S, E1);
    }
    SEAM(1); TS(2);
    if (IN(2)) { scan_prompt(F, 0); }
    SEAM(2); TS(3);
    if (IN(3)) {
        pg8::Gemm g{XB + (size_t)PA_ROWS * D, (const bf16_t*)(F.ws + WS_W1T), PB_ROWS, RWIN_PAD, D, D}; pg8::StaticOrder S; S.init(PB_ROWS, RWIN_PAD, F.G, F.bid);
        Epi1 E1{PROJH, F.misc + MI_RS0 + PA_ROWS, 1, F.out + OFF_PSHIFT, F.out + OFF_SSHIFT, F.misc + MI_CARRY};
        pg8::gemm_phase<Epi1>((LAS unsigned char*)lds, g, S, E1);
    }
    SEAM(3); TS(4);
    if (IN(4)) { scan_prompt(F, 1); scan_samples(F); }
    SEAM(4); TS(5);
    if (IN(5)) {
        pg8::Gemm g{(const bf16_t*)(F.ws + WS_O), (const bf16_t*)(F.ws + WS_W2T), MTOT, D, E, E}; pg8::StaticOrder S; S.init(MTOT, D, F.G, F.bid);
        Epi2 E2{F.in[0], F.in[1], F.out + OFF_Y, (bf16_t*)(F.ws + WS_X1B), F.misc + MI_SS1};
        pg8::gemm_phase<Epi2>((LAS unsigned char*)lds, g, S, E2);
#ifdef PROBE_KLOOP
        __syncthreads();
        Epi2 EN{F.in[0], F.in[1], F.out + OFF_Y, (bf16_t*)(F.ws + WS_X1B), nullptr};
        pg8::gemm_phase<Epi2>((LAS unsigned char*)lds, g, S, EN);
#endif
    }
    SEAM(5); TS(6);
    if (IN(6)) {
        pg8::Gemm g{(const bf16_t*)(F.ws + WS_X1B), (const bf16_t*)(F.ws + WS_W3T), MTOT, GMIN, D, D}; pg8::StaticOrder S; S.init(MTOT, GMIN, F.G, F.bid);
        Epi3 E3{(bf16_t*)(F.ws + WS_PROJ2), F.misc + MI_SS1, F.misc + MI_VSUM, F.misc + MI_VSQ};
        pg8::gemm_phase<Epi3>((LAS unsigned char*)lds, g, S, E3);
    }
    SEAM(6); TS(7);
    if (IN(7)) { phase_gate(F); }
    SEAM(7); TS(8);
    if (IN(8)) {
        pg8::Gemm g{(const bf16_t*)(F.ws + WS_PROJ2), (const bf16_t*)(F.ws + WS_W4T), MTOT, D, E, GMIN}; pg8::StaticOrder S; S.init(MTOT, D, F.G, F.bid);
        Epi4 E4{F.out + OFF_Y, F.misc + MI_SS2, (const bf16_t*)(F.ws + WS_X1B)};
        pg8::gemm_phase<Epi4>((LAS unsigned char*)lds, g, S, E4);
    }
    SEAM(8); TS(9);
    if (IN(9)) { phase_final(F); }
#ifdef PROBE_LO
    if (F.bid == 0 && F.tid == 0) { const unsigned long long tend = __builtin_amdgcn_s_memrealtime(); tsb[10] = tend; __threadfence();
        const unsigned long long dt = tsb[PROBE_HI] - tsb[PROBE_LO];
        while (__builtin_amdgcn_s_memrealtime() - tend < dt) __builtin_amdgcn_s_sleep(8); }
#endif
#undef IN
#undef SEAM
}

constexpr int NPHASES = 10;
extern "C" void kernel_launch(void* const* d_in, const int* in_sizes, int n_in, void* d_out, int out_size, void* d_ws, size_t ws_size, hipStream_t stream) {
    static int grid = 0;
    if (grid == 0) {
        int dev = 0, cus = 0, per_cu = 0;
        hipGetDevice(&dev);
        hipDeviceGetAttribute(&cus, hipDeviceAttributeMultiprocessorCount, dev);
        hipFuncSetAttribute((const void*)fwd_kernel, hipFuncAttributeMaxDynamicSharedMemorySize, LDS_BYTES);
        hipOccupancyMaxActiveBlocksPerMultiprocessor(&per_cu, (const void*)fwd_kernel, NTHREADS, LDS_BYTES);
        if (per_cu < 1) per_cu = 1;
        grid = cus * per_cu;
        if (grid > 256) grid = 256;
        (void)hipGetLastError();
    }
    Params p{};
    for (int i = 0; i < 24; ++i) p.in[i] = (const float*)d_in[i];
    p.out = (float*)d_out; p.ws = (unsigned char*)d_ws;
#if MK_ONE_LAUNCH
    p.ph_lo = 0; p.ph_hi = NPHASES;
    (void)hipMemsetAsync((unsigned char*)d_ws + WS_BAR, 0, 16384, stream);
    void* args[] = {&p};
    hipError_t e = hipLaunchCooperativeKernel((const void*)fwd_kernel, dim3(grid), dim3(NTHREADS), args, LDS_BYTES, stream);
    if (e != hipSuccess) fprintf(stderr, "cooperative launch failed: %s (grid %d)\n", hipGetErrorString(e), grid);
#else
    for (int ph = 0; ph < NPHASES; ++ph) {
        p.ph_lo = ph; p.ph_hi = ph + 1;
        hipLaunchKernelGGL(fwd_kernel, dim3(grid), dim3(NTHREADS), LDS_BYTES, stream, p);
    }
#endif
}
```
